# Optimizing an MI355X kernel written in HIP

```python
import math
import jax, jax.numpy as jnp
from jax import lax
import numpy as np

D_MODEL = 1024
BATCH = 2
SEQ = 8192
DEPTH = 1

D_MIX = D_MODEL
ATT_HEADS = 8
HEAD_DIM = 64
D_ATT = ATT_HEADS * HEAD_DIM
D_CONV = D_MIX - D_ATT
DILATED_PATTERNS = ((128, 1), (512, 4), (2048, 16))
ROPE_THETA = 500000.0
ROT_DIM = HEAD_DIM // 4
CONV_WIDTH = 31
N_MEM = 256
XATT_HEADS = 4
XATT_HEAD_DIM = D_MODEL // XATT_HEADS
D_FF = 4 * D_MODEL
D_IN = 3 * D_ATT + 2 * D_CONV
EPS = 1e-6
NEG_INF = -1e30

kernel_name = "hybrid_dilated_swa_conformer_encoder"


def rmsnorm(x, g):
    xf = x.astype(jnp.float32)
    var = jnp.mean(xf * xf, axis=-1, keepdims=True)
    return (xf * lax.rsqrt(var + EPS) * g.astype(jnp.float32)).astype(x.dtype)


def layernorm(x, g, b):
    xf = x.astype(jnp.float32)
    mu = jnp.mean(xf, axis=-1, keepdims=True)
    var = jnp.mean(jnp.square(xf - mu), axis=-1, keepdims=True)
    y = (xf - mu) * lax.rsqrt(var + EPS) * g.astype(jnp.float32) + b.astype(jnp.float32)
    return y.astype(x.dtype)


def partial_rotary(t):
    S = t.shape[1]
    half = ROT_DIM // 2
    freqs = ROPE_THETA ** (-jnp.arange(0, ROT_DIM, 2, dtype=jnp.float32) / ROT_DIM)
    ang = jnp.arange(S, dtype=jnp.float32)[:, None] * freqs[None, :]
    cos = jnp.cos(ang)[None, :, None, :]
    sin = jnp.sin(ang)[None, :, None, :]
    tf = t.astype(jnp.float32)
    x1, x2, rest = tf[..., :half], tf[..., half:ROT_DIM], tf[..., ROT_DIM:]
    rot = jnp.concatenate([x1 * cos - x2 * sin, x2 * cos + x1 * sin, rest], axis=-1)
    return rot.astype(t.dtype)


def to_strided(t, d):
    B, S = t.shape[:2]
    rest = t.shape[2:]
    t = jnp.moveaxis(t.reshape(B, S // d, d, *rest), 2, 1)
    return t.reshape(B * d, S // d, *rest)


def from_strided(t, d, B):
    N, L = t.shape[:2]
    rest = t.shape[2:]
    t = jnp.moveaxis(t.reshape(B, d, L, *rest), 1, 2)
    return t.reshape(B, L * d, *rest)


def banded_attention(q, k, v, half):
    N, L, H, Dh = q.shape
    blk = half
    nb = -(-L // blk)
    Lp = nb * blk
    pad = Lp - L
    qb = jnp.pad(q, ((0, 0), (0, pad), (0, 0), (0, 0))).reshape(N, nb, blk, H, Dh)
    kp = jnp.pad(k, ((0, 0), (blk, blk + pad), (0, 0), (0, 0)))
    vp = jnp.pad(v, ((0, 0), (blk, blk + pad), (0, 0), (0, 0)))

    def window(t):
        return jnp.concatenate(
            [t[:, i * blk:i * blk + Lp].reshape(N, nb, blk, H, Dh) for i in range(3)], axis=2)

    kb, vb = window(kp), window(vp)
    s = jnp.einsum('nbqhd,nbkhd->nbhqk', qb, kb).astype(jnp.float32) * (Dh ** -0.5)
    qpos = jnp.arange(nb)[:, None] * blk + jnp.arange(blk)[None, :]
    kpos = jnp.arange(nb)[:, None] * blk - blk + jnp.arange(3 * blk)[None, :]
    valid = ((jnp.abs(kpos[:, None, :] - qpos[:, :, None]) <= half)
             & (kpos >= 0)[:, None, :] & (kpos < L)[:, None, :])
    s = jnp.where(valid[None, :, None], s, NEG_INF)
    m = jnp.max(s, axis=-1, keepdims=True)
    p = jnp.exp(s - m)
    den = jnp.sum(p, axis=-1, keepdims=True)
    o = jnp.einsum('nbhqk,nbkhd->nbqhd', (p / den).astype(v.dtype), vb)
    lse = (m + jnp.log(den))[..., 0]
    o = o.reshape(N, Lp, H, Dh)[:, :L]
    lse = jnp.transpose(lse, (0, 1, 3, 2)).reshape(N, Lp, H)[:, :L]
    return o, lse


def dilated_sliding_attention(q, k, v):
    B = q.shape[0]
    outs, lses = [], []
    for window, d in DILATED_PATTERNS:
        half = window // (2 * d)
        o, lse = banded_attention(to_strided(q, d), to_strided(k, d), to_strided(v, d), half)
        outs.append(from_strided(o, d, B))
        lses.append(from_strided(lse, d, B))
    w = jax.nn.softmax(jnp.stack(lses, axis=0), axis=0)
    o = jnp.sum(w[..., None] * jnp.stack(outs, axis=0).astype(jnp.float32), axis=0)
    return o.astype(q.dtype)


def conformer_conv(a, g, conv_w, conv_b, ln_g, ln_b):
    u = a * jax.nn.sigmoid(g)
    C = u.shape[-1]
    u = lax.conv_general_dilated(
        u, conv_w.reshape(CONV_WIDTH, 1, C).astype(u.dtype),
        window_strides=(1,), padding=[((CONV_WIDTH - 1) // 2, (CONV_WIDTH - 1) // 2)],
        dimension_numbers=('NWC', 'WIO', 'NWC'), feature_group_count=C) + conv_b
    u = layernorm(u, ln_g, ln_b)
    return jax.nn.silu(u)


def setup_inputs(seed: int = 0) -> dict:
    key = jax.random.key(seed)
    ks = jax.random.split(key, 20)
    f32 = jnp.float32

    def w(k, shape, fan_in):
        return jax.random.normal(k, shape, f32) * (fan_in ** -0.5)

    def gain(k, shape):
        return 1.0 + 0.02 * jax.random.normal(k, shape, f32)

    return {
        "x": jax.random.normal(ks[0], (BATCH, SEQ, D_MODEL), f32),
        "mem": jax.random.normal(ks[1], (BATCH, N_MEM, D_MODEL), f32),
        "norm_mix_g": gain(ks[2], (DEPTH, D_MODEL)),
        "w_in": w(ks[3], (DEPTH, D_MODEL, D_IN), D_MODEL),
        "conv_w": w(ks[4], (DEPTH, CONV_WIDTH, D_CONV), CONV_WIDTH),
        "conv_b": 0.02 * jax.random.normal(ks[5], (DEPTH, D_CONV), f32),
        "conv_ln_g": gain(ks[6], (DEPTH, D_CONV)),
        "conv_ln_b": 0.02 * jax.random.normal(ks[7], (DEPTH, D_CONV), f32),
        "w_out": w(ks[8], (DEPTH, D_MIX, D_MODEL), D_MIX),
        "norm_x_g": gain(ks[9], (DEPTH, D_MODEL)),
        "norm_mem_g": gain(ks[10], (DEPTH, D_MODEL)),
        "w_xq": w(ks[11], (DEPTH, D_MODEL, D_MODEL), D_MODEL),
        "w_xk": w(ks[12], (DEPTH, D_MODEL, D_MODEL), D_MODEL),
        "w_xv": w(ks[13], (DEPTH, D_MODEL, D_MODEL), D_MODEL),
        "w_xo": w(ks[14], (DEPTH, D_MODEL, D_MODEL), D_MODEL),
        "norm_mlp_g": gain(ks[15], (DEPTH, D_MODEL)),
        "w_up": w(ks[16], (DEPTH, D_MODEL, D_FF), D_MODEL),
        "w_down": w(ks[17], (DEPTH, D_FF, D_MODEL), D_FF),
        "norm_final_g": gain(ks[18], (D_MODEL,)),
    }


def reference(x, mem, norm_mix_g, w_in, conv_w, conv_b, conv_ln_g, conv_ln_b, w_out,
              norm_x_g, norm_mem_g, w_xq, w_xk, w_xv, w_xo, norm_mlp_g, w_up, w_down,
              norm_final_g):
    B, S, _ = x.shape
    M = mem.shape[1]
    h = x
    for l in range(DEPTH):
        y = rmsnorm(h, norm_mix_g[l]) @ w_in[l]
        q = partial_rotary(y[..., 0:D_ATT].reshape(B, S, ATT_HEADS, HEAD_DIM))
        k = partial_rotary(y[..., D_ATT:2 * D_ATT].reshape(B, S, ATT_HEADS, HEAD_DIM))
        v = y[..., 2 * D_ATT:3 * D_ATT].reshape(B, S, ATT_HEADS, HEAD_DIM)
        att = dilated_sliding_attention(q, k, v).reshape(B, S, D_ATT)
        c0 = 3 * D_ATT
        conv = conformer_conv(y[..., c0:c0 + D_CONV], y[..., c0 + D_CONV:c0 + 2 * D_CONV],
                              conv_w[l], conv_b[l], conv_ln_g[l], conv_ln_b[l])
        h = h + jnp.concatenate([att, conv], axis=-1) @ w_out[l]

        xq = (rmsnorm(h, norm_x_g[l]) @ w_xq[l]).reshape(B, S, XATT_HEADS, XATT_HEAD_DIM)
        mn = rmsnorm(mem, norm_mem_g[l])
        xk = (mn @ w_xk[l]).reshape(B, M, XATT_HEADS, XATT_HEAD_DIM)
        xv = (mn @ w_xv[l]).reshape(B, M, XATT_HEADS, XATT_HEAD_DIM)
        sc = jnp.einsum('bshd,bmhd->bhsm', xq, xk).astype(jnp.float32) * (XATT_HEAD_DIM ** -0.5)
        pr = jax.nn.softmax(sc, axis=-1).astype(xv.dtype)
        xo = jnp.einsum('bhsm,bmhd->bshd', pr, xv).reshape(B, S, D_MODEL)
        h = h + xo @ w_xo[l]

        u = rmsnorm(h, norm_mlp_g[l]) @ w_up[l]
        h = h + jnp.square(jax.nn.relu(u)) @ w_down[l]
    return rmsnorm(h, norm_final_g)
```

```cpp
#include <hip/hip_runtime.h>
#include <hip/hip_cooperative_groups.h>
#include <cstdio>
#include <cstdint>
namespace cg = cooperative_groups;
namespace pg8 {
#define PG8_LAS __attribute__((address_space(3)))
typedef unsigned short bf16_t;
typedef short bf16x8 __attribute__((ext_vector_type(8)));
typedef float f32x4 __attribute__((ext_vector_type(4)));
typedef unsigned u32x4 __attribute__((ext_vector_type(4)));
constexpr int BM = 256, BK = 64, HALF = 128, HTB = HALF * BK * 2  , STAGE_BYTES = 8 * HTB, NXCD = 8, WGM = 8;

__host__ __device__ __forceinline__ int lds_byte(int r, int c) { const int st = (r >> 4) * 2 + (c >> 5), rr = r & 15, cc = c & 31, ob = rr * 64 + cc * 2; return st * 1024 + (ob ^ (((ob >> 9) & 1) << 5)); }
__host__ __device__ __forceinline__ void stage_rc(int b, int& R, int& C) { const int st = b / 1024, sb = b % 1024, swz = sb ^ (((sb >> 9) & 1) << 5); R = (st >> 1) * 16 + swz / 64; C = (st & 1) * 32 + (swz % 64) / 2; }
__host__ __device__ __forceinline__ int perm32(int rho) { const int n = rho >> 4, i = rho & 15; return 8 * (i >> 2) + 4 * n + (i & 3); }

struct Unit { int pm, pn; };
struct Gemm { const bf16_t* A; const bf16_t* Bt; int M, N, K; };

struct StaticOrder {
    int nM, nN, nwg, G, c;
    __host__ __device__ void init(int M, int N, int G_, int c_) { nM = M / BM; nN = N / BM; nwg = nM * nN; G = G_; c = c_; }
    __host__ __device__ bool next(int i, Unit& u) const {
        const long L = (long)i * G + c; if (L >= nwg) return false;
        int wgid = (int)L; { const int q = nwg / NXCD, r = nwg % NXCD, xcd = wgid % NXCD, off = wgid / NXCD; wgid = (xcd < r ? xcd * (q + 1) : r * (q + 1) + (xcd - r) * q) + off; }
        const int nig = WGM * nN, gid = wgid / nig, fm = gid * WGM, gsz = (nM - fm) < WGM ? (nM - fm) : WGM;
        u.pm = fm + ((wgid % nig) % gsz); u.pn = (wgid % nig) / gsz; return true;
    }
    __device__ __forceinline__ void a_ready(const Unit&) const {}
    __device__ __forceinline__ void done(const Unit&) const {}
};
__device__ __forceinline__ unsigned cvt_pk_bf16(float lo, float hi) { unsigned r; asm volatile("v_cvt_pk_bf16_f32 %0, %1, %2" : "=v"(r) : "v"(lo), "v"(hi)); return r; }
template <class Epi, class Sched, bool ALIGN_EPI = false, bool SP2 = false>
__device__ __forceinline__ void gemm_phase(PG8_LAS unsigned char* lds, const Gemm g, const Sched& S, const Epi& E) {
    const int tid = threadIdx.x, wid = __builtin_amdgcn_readfirstlane(tid >> 6), lane = tid & 63, wr = wid >> 2, wc = wid & 3, fr = lane & 15, fq = lane >> 4;
    const int K = g.K, nt = K / BK;
    unsigned voffA[2], voffB[2];
#pragma unroll
    for (int i = 0; i < 2; ++i) { int R, C; stage_rc(tid * 16 + i * 8192, R, C); const int Rb = Epi::PERM ? ((R & ~31) + perm32(R & 31)) : R;
        voffA[i] = (unsigned)(R * K + C) * 2u; voffB[i] = (unsigned)(Rb * K + C) * 2u; }
    const size_t kstep = (size_t)(BK * 2);
    const size_t hstep = (size_t)HALF * K * 2;
    const size_t tstep = 2 * hstep;
    const unsigned ldsw = (unsigned)wid * 1024u;
    const int aoff = lds_byte(wr * 64 + fr, fq * 8), boff = lds_byte(wc * 32 + fr, fq * 8);
#define PG8_SA(b, h) (((b) * 2 + (h)) * HTB)
#define PG8_SB(b, h) ((4 + (b) * 2 + (h)) * HTB)
#define PG8_STAGE(bufoff, gbase, voff) do { _Pragma("unroll") for (int _i = 0; _i < 2; ++_i) \
        __builtin_amdgcn_global_load_lds((const unsigned*)((const char*)(gbase) + (voff)[_i]), (PG8_LAS unsigned*)(lds + (bufoff) + ldsw + _i * 8192), 16, 0, 0); } while (0)
#define PG8_LDA(dst, b, h) do { _Pragma("unroll") for (int m = 0; m < 4; ++m) _Pragma("unroll") for (int k = 0; k < 2; ++k) dst[m][k] = *(const PG8_LAS bf16x8*)(lds + PG8_SA(b, h) + aoff + m * 2048 + k * 1024); } while (0)
#define PG8_LDB(dst, b, h) do { _Pragma("unroll") for (int n = 0; n < 2; ++n) _Pragma("unroll") for (int k = 0; k < 2; ++k) dst[n][k] = *(const PG8_LAS bf16x8*)(lds + PG8_SB(b, h) + boff + n * 2048 + k * 1024); } while (0)
#define PG8_MMA(ai, bj, At, Bt) do { __builtin_amdgcn_s_setprio(1); _Pragma("unroll") for (int m = 0; m < 4; ++m) _Pragma("unroll") for (int n = 0; n < 2; ++n) _Pragma("unroll") for (int k = 0; k < 2; ++k) \
        acc[ai][bj][m][n] = __builtin_amdgcn_mfma_f32_16x16x32_bf16(Bt[n][k], At[m][k], acc[ai][bj][m][n], 0, 0, 0); __builtin_amdgcn_s_setprio(0); } while (0)
#define PG8_WAIT_V(n) asm volatile("s_waitcnt vmcnt(" #n ")" ::: "memory")
#define PG8_WAIT_L(n) asm volatile("s_waitcnt lgkmcnt(" #n ")" ::: "memory")
#define PG8_BAR __builtin_amdgcn_s_barrier()
#define PG8_SCHED __builtin_amdgcn_sched_barrier(0)
    Unit cur, nxt; int ui = 0;
    if (!S.next(0, cur)) return;
    f32x4 acc[2][2][4][2];
#pragma unroll
    for (int a = 0; a < 2; ++a)
#pragma unroll
        for (int b = 0; b < 2; ++b)
#pragma unroll
            for (int m = 0; m < 4; ++m)
#pragma unroll
                for (int n = 0; n < 2; ++n) acc[a][b][m][n] = (f32x4){0.f, 0.f, 0.f, 0.f};
    bf16x8 At[4][2], B0[2][2], B1[2][2];
    const char* cA = (const char*)g.A + (size_t)cur.pm * tstep; const char* cB = (const char*)g.Bt + (size_t)cur.pn * tstep;
    S.a_ready(cur);
    if constexpr (SP2) {
        PG8_STAGE(PG8_SB(0, 0), cB, voffB); PG8_STAGE(PG8_SB(0, 1), cB + hstep, voffB); PG8_STAGE(PG8_SA(0, 0), cA, voffA); PG8_STAGE(PG8_SA(0, 1), cA + hstep, voffA);
        if (wr == 1) PG8_BAR;
        PG8_WAIT_V(2); PG8_BAR;
        PG8_STAGE(PG8_SB(1, 0), cB + kstep, voffB); PG8_STAGE(PG8_SA(1, 0), cA + kstep, voffA); PG8_STAGE(PG8_SB(1, 1), cB + hstep + kstep, voffB);
        PG8_WAIT_V(6); PG8_BAR;
    } else {
        PG8_STAGE(PG8_SB(0, 0), cB, voffB); PG8_STAGE(PG8_SA(0, 0), cA, voffA); PG8_STAGE(PG8_SB(0, 1), cB + hstep, voffB); PG8_STAGE(PG8_SA(0, 1), cA + hstep, voffA);
        if (wr == 1) PG8_BAR;
        PG8_WAIT_V(4); PG8_BAR;
        PG8_STAGE(PG8_SB(1, 0), cB + kstep, voffB); PG8_STAGE(PG8_SA(1, 0), cA + kstep, voffA); PG8_STAGE(PG8_SB(1, 1), cB + hstep + kstep, voffB);
        PG8_WAIT_V(6); PG8_BAR;
    }
    for (;;) {
        const bool has_next = S.next(ui + 1, nxt);
        const char* nA = has_next ? (const char*)g.A + (size_t)nxt.pm * tstep : cA; const char* nB = has_next ? (const char*)g.Bt + (size_t)nxt.pn * tstep : cB;
        for (int t = 0; t < nt; t += 2) {
            const bool last = (t == nt - 2);
            const char* a1 = cA + (size_t)(t + 1) * kstep;
            const char* a2 = last ? nA : cA + (size_t)(t + 2) * kstep; const char* b2 = last ? nB : cB + (size_t)(t + 2) * kstep;
            const char* a3 = a2 + kstep; const char* b3 = b2 + kstep;
            if (last && has_next) S.a_ready(nxt);
            if constexpr (SP2) {
            PG8_LDB(B0, 0, 0); PG8_LDB(B1, 0, 1); PG8_SCHED; PG8_LDA(At, 0, 0); PG8_STAGE(PG8_SA(1, 1), a1 + hstep, voffA);
            PG8_WAIT_V(8); PG8_WAIT_L(0); PG8_BAR; PG8_MMA(0, 0, At, B0); PG8_MMA(0, 1, At, B1); PG8_BAR; PG8_SCHED;
            PG8_LDA(At, 0, 1); PG8_STAGE(PG8_SB(0, 0), b2, voffB); PG8_STAGE(PG8_SB(0, 1), b2 + hstep, voffB); PG8_STAGE(PG8_SA(0, 0), a2, voffA);
            PG8_WAIT_V(8); PG8_WAIT_L(0); PG8_BAR; PG8_MMA(1, 0, At, B0); PG8_MMA(1, 1, At, B1); PG8_BAR; PG8_SCHED;
            PG8_LDB(B0, 1, 0); PG8_LDB(B1, 1, 1); PG8_SCHED; PG8_LDA(At, 1, 0); PG8_STAGE(PG8_SA(0, 1), a2 + hstep, voffA);
            PG8_WAIT_V(8); PG8_WAIT_L(0); PG8_BAR; PG8_MMA(0, 0, At, B0); PG8_MMA(0, 1, At, B1); PG8_BAR; PG8_SCHED;
            PG8_LDA(At, 1, 1); PG8_STAGE(PG8_SB(1, 0), b3, voffB); PG8_STAGE(PG8_SB(1, 1), b3 + hstep, voffB); PG8_STAGE(PG8_SA(1, 0), a3, voffA);
            PG8_WAIT_V(8); PG8_WAIT_L(0); PG8_BAR; PG8_MMA(1, 0, At, B0); PG8_MMA(1, 1, At, B1); PG8_BAR; PG8_SCHED;
            } else {
            PG8_LDB(B0, 0, 0); PG8_SCHED; PG8_LDA(At, 0, 0); PG8_STAGE(PG8_SA(1, 1), a1 + hstep, voffA);
            PG8_WAIT_L(8); PG8_BAR; PG8_WAIT_L(0); PG8_MMA(0, 0, At, B0); PG8_BAR; PG8_SCHED;
            PG8_LDB(B1, 0, 1); PG8_STAGE(PG8_SB(0, 0), b2, voffB);
            PG8_BAR; PG8_WAIT_L(0); PG8_MMA(0, 1, At, B1); PG8_BAR;
            PG8_LDA(At, 0, 1); PG8_STAGE(PG8_SA(0, 0), a2, voffA);
            PG8_BAR; PG8_WAIT_L(0); PG8_MMA(1, 0, At, B0); PG8_BAR; PG8_SCHED;
            PG8_STAGE(PG8_SB(0, 1), b2 + hstep, voffB);
            PG8_WAIT_V(6); PG8_BAR; PG8_MMA(1, 1, At, B1); PG8_BAR;
            PG8_LDB(B0, 1, 0); PG8_SCHED; PG8_LDA(At, 1, 0); PG8_STAGE(PG8_SA(0, 1), a2 + hstep, voffA);
            PG8_WAIT_L(8); PG8_BAR; PG8_WAIT_L(0); PG8_MMA(0, 0, At, B0); PG8_BAR; PG8_SCHED;
            PG8_LDB(B1, 1, 1); PG8_STAGE(PG8_SB(1, 0), b3, voffB);
            PG8_BAR; PG8_WAIT_L(0); PG8_MMA(0, 1, At, B1); PG8_BAR;
            PG8_LDA(At, 1, 1); PG8_STAGE(PG8_SA(1, 0), a3, voffA);
            PG8_BAR; PG8_WAIT_L(0); PG8_MMA(1, 0, At, B0); PG8_BAR; PG8_SCHED;
            PG8_STAGE(PG8_SB(1, 1), b3 + hstep, voffB);
            PG8_WAIT_V(6); PG8_BAR; PG8_MMA(1, 1, At, B1); PG8_BAR;
            }
        }
        if constexpr (ALIGN_EPI) { if (wr == 0) PG8_BAR; }
        if constexpr (!Epi::AFTER_DRAIN) { E(acc, cur, wr, wc, fr, fq); S.done(cur); }
        if (!has_next) break;
#pragma unroll
        for (int a = 0; a < 2; ++a)
#pragma unroll
            for (int b = 0; b < 2; ++b)
#pragma unroll
                for (int m = 0; m < 4; ++m)
#pragma unroll
                    for (int n = 0; n < 2; ++n) acc[a][b][m][n] = (f32x4){0.f, 0.f, 0.f, 0.f};
        cur = nxt; cA = nA; cB = nB; ++ui;
        if constexpr (ALIGN_EPI) { if (wr == 1) PG8_BAR; }
    }
    PG8_WAIT_V(0);
    if constexpr (!ALIGN_EPI) { if (wr == 0) PG8_BAR; }
    PG8_BAR;
    if constexpr (Epi::AFTER_DRAIN) { E.fused(acc, cur, wr, wc, fr, fq, lds, wid, lane); S.done(cur); }
#undef PG8_SA
#undef PG8_SB
#undef PG8_STAGE
#undef PG8_LDA
#undef PG8_LDB
#undef PG8_MMA
#undef PG8_WAIT_V
#undef PG8_WAIT_L
#undef PG8_BAR
#undef PG8_SCHED
}
}

constexpr int SEQ = 8192, BATCH = 2, M = BATCH * SEQ, D = 1024, DIN = 2560, FF = 4096, NMEM = 256, MM = BATCH * NMEM;
constexpr float EPS = 1e-6f;
constexpr float LOG2E = 1.4426950408889634f;
constexpr float QSCALE = 0.125f * LOG2E;
constexpr float XQSCALE = 0.0625f * LOG2E;

typedef unsigned short bf16_t;
using pg8::bf16x8; using pg8::f32x4; using pg8::u32x4;
typedef short s16x4 __attribute__((ext_vector_type(4)));
typedef short v4i16_t __attribute__((ext_vector_type(4)));
typedef float f32x2 __attribute__((ext_vector_type(2)));
typedef unsigned u32x2 __attribute__((ext_vector_type(2)));
#define LAS __attribute__((address_space(3)))

constexpr size_t MiB = 1u << 20;
constexpr size_t WS_CS = 1 * MiB, WS_SS1 = 2 * MiB, WS_SS2 = 3 * MiB, WS_SS3 = 4 * MiB, WS_LSE = 5 * MiB, WS_MN = 7 * MiB, WS_XK = 8 * MiB, WS_XV = 9 * MiB;
constexpr size_t WS_WIN = 10 * MiB, WS_WOUT = 15 * MiB, WS_WXQ = 17 * MiB, WS_WXKV = 19 * MiB, WS_WXO = 23 * MiB, WS_WUP = 25 * MiB, WS_WDN = 33 * MiB;
constexpr size_t WS_XN = 42 * MiB, WS_QB = 74 * MiB, WS_KB = 90 * MiB, WS_VB = 106 * MiB, WS_UC = 122 * MiB, WS_MIX = 138 * MiB, WS_OP = 170 * MiB;
constexpr size_t WS_XQ = 74 * MiB, WS_XO = 106 * MiB, WS_U = 74 * MiB, WS_END = 218 * MiB;
constexpr int LDS_BYTES = 147456;
constexpr int NPH = 11;

struct Args { const float* in[19]; float* out; unsigned char* ws; int ph_lo, ph_hi; };

__device__ __forceinline__ unsigned pk2(float lo, float hi) { return pg8::cvt_pk_bf16(lo, hi); }
__device__ __forceinline__ float bflo(unsigned w) { return __uint_as_float(w << 16); }
__device__ __forceinline__ float bfhi(unsigned w) { return __uint_as_float(w & 0xffff0000u); }
__device__ __forceinline__ float wave_sum(float v) {
#pragma unroll
    for (int o = 1; o < 64; o <<= 1) v += __shfl_xor(v, o);
    return v;
}
#define MFMA16(a, b, c) __builtin_amdgcn_mfma_f32_16x16x32_bf16((a), (b), (c), 0, 0, 0)
__device__ __forceinline__ s16x4 vtr(const LAS unsigned char* p) { return __builtin_bit_cast(s16x4, __builtin_amdgcn_ds_read_tr16_b64_v4i16((LAS v4i16_t*)p)); }

struct EpiIn {
    static constexpr bool PERM = true, AFTER_DRAIN = false;
    bf16_t *Qb, *Kb, *Vb, *UC; const float* CS;
    __device__ __forceinline__ void operator()(const f32x4 (&acc)[2][2][4][2], const pg8::Unit& u, int wr, int wc, int fr, int fq) const {
        const int row0 = u.pm * 256 + wr * 64 + fr;
        if (u.pn >= 6) {
            const int ch0 = (u.pn - 6) * 128 + wc * 32 + 8 * fq;
#pragma unroll
            for (int ai = 0; ai < 2; ++ai)
#pragma unroll
                for (int m = 0; m < 4; ++m) {
                    const int row = row0 + ai * 128 + m * 16;
                    float r[8];
#pragma unroll
                    for (int n = 0; n < 2; ++n)
#pragma unroll
                        for (int j = 0; j < 4; ++j) { const float a = acc[ai][0][m][n][j], g = acc[ai][1][m][n][j]; r[4 * n + j] = a / (1.f + __expf(-g)); }
                    u32x4 w; w.x = pk2(r[0], r[1]); w.y = pk2(r[2], r[3]); w.z = pk2(r[4], r[5]); w.w = pk2(r[6], r[7]);
                    *(u32x4*)(UC + (size_t)row * 512 + ch0) = w;
                }
        } else if (u.pn >= 4) {
            const int col0 = (u.pn - 4) * 256 + wc * 32 + 8 * fq;
#pragma unroll
            for (int ai = 0; ai < 2; ++ai)
#pragma unroll
                for (int m = 0; m < 4; ++m) {
                    const int row = row0 + ai * 128 + m * 16;
#pragma unroll
                    for (int bj = 0; bj < 2; ++bj) {
                        const f32x4 v0 = acc[ai][bj][m][0], v1 = acc[ai][bj][m][1];
                        u32x4 w; w.x = pk2(v0[0], v0[1]); w.y = pk2(v0[2], v0[3]); w.z = pk2(v1[0], v1[1]); w.w = pk2(v1[2], v1[3]);
                        *(u32x4*)(Vb + (size_t)row * 512 + col0 + bj * 128) = w;
                    }
                }
        } else {
            bf16_t* dst = (u.pn < 2) ? Qb : Kb; const float sc = (u.pn < 2) ? QSCALE : 1.f;
            const int col0 = (u.pn & 1) * 256 + wc * 32 + 8 * fq;
            const bool rope_wave = (wc & 1) == 0;
            const float sgn = (fq == 0) ? -1.f : 1.f;
#pragma unroll
            for (int ai = 0; ai < 2; ++ai)
#pragma unroll
                for (int m = 0; m < 4; ++m) {
                    const int row = row0 + ai * 128 + m * 16;
                    const int pos = row & (SEQ - 1);
                    f32x4 cs[4];
                    if (rope_wave && fq < 2) {
#pragma unroll
                        for (int q = 0; q < 4; ++q) cs[q] = *(const f32x4*)(CS + (size_t)pos * 16 + 4 * q);
                    }
#pragma unroll
                    for (int bj = 0; bj < 2; ++bj) {
                        float v[8];
#pragma unroll
                        for (int n = 0; n < 2; ++n)
#pragma unroll
                            for (int j = 0; j < 4; ++j) v[4 * n + j] = acc[ai][bj][m][n][j];
                        if (rope_wave) {
#pragma unroll
                            for (int i = 0; i < 8; ++i) {
                                const float p = __shfl_xor(v[i], 16);
                                if (fq < 2) { const float c = cs[i >> 1][2 * (i & 1)], s = cs[i >> 1][2 * (i & 1) + 1]; v[i] = v[i] * c + sgn * p * s; }
                            }
                        }
                        u32x4 w; w.x = pk2(v[0] * sc, v[1] * sc); w.y = pk2(v[2] * sc, v[3] * sc); w.z = pk2(v[4] * sc, v[5] * sc); w.w = pk2(v[6] * sc, v[7] * sc);
                        *(u32x4*)(dst + (size_t)row * 512 + col0 + bj * 128) = w;
                    }
                }
        }
    }
};
struct EpiKV {
    static constexpr bool PERM = true, AFTER_DRAIN = false;
    bf16_t *XK, *XV;
    __device__ __forceinline__ void operator()(const f32x4 (&acc)[2][2][4][2], const pg8::Unit& u, int wr, int wc, int fr, int fq) const {
        const int row0 = u.pm * 256 + wr * 64 + fr;
        bf16_t* dst = (u.pn < 4) ? XK : XV; const int col0 = (u.pn & 3) * 256 + wc * 32 + 8 * fq;
#pragma unroll
        for (int ai = 0; ai < 2; ++ai)
#pragma unroll
            for (int m = 0; m < 4; ++m) {
                const int row = row0 + ai * 128 + m * 16;
#pragma unroll
                for (int bj = 0; bj < 2; ++bj) {
                    const f32x4 v0 = acc[ai][bj][m][0], v1 = acc[ai][bj][m][1];
                    u32x4 w; w.x = pk2(v0[0], v0[1]); w.y = pk2(v0[2], v0[3]); w.z = pk2(v1[0], v1[1]); w.w = pk2(v1[2], v1[3]);
                    *(u32x4*)(dst + (size_t)row * 1024 + col0 + bj * 128) = w;
                }
            }
    }
};
struct EpiRes {
    static constexpr bool PERM = true, AFTER_DRAIN = false;
    const float* base; float* out; bf16_t* xn; float* ss;
    __device__ __forceinline__ void operator()(const f32x4 (&acc)[2][2][4][2], const pg8::Unit& u, int wr, int wc, int fr, int fq) const {
        const int row0 = u.pm * 256 + wr * 64 + fr; const int col0 = u.pn * 256 + wc * 32 + 8 * fq;
#pragma unroll
        for (int ai = 0; ai < 2; ++ai)
#pragma unroll
            for (int m = 0; m < 4; ++m) {
                const int row = row0 + ai * 128 + m * 16;
                float s = 0.f;
#pragma unroll
                for (int bj = 0; bj < 2; ++bj) {
                    const size_t o = (size_t)row * D + col0 + bj * 128;
                    const f32x4 v0 = acc[ai][bj][m][0] + *(const f32x4*)(base + o), v1 = acc[ai][bj][m][1] + *(const f32x4*)(base + o + 4);
                    *(f32x4*)(out + o) = v0; *(f32x4*)(out + o + 4) = v1;
                    if (xn) { u32x4 w; w.x = pk2(v0[0], v0[1]); w.y = pk2(v0[2], v0[3]); w.z = pk2(v1[0], v1[1]); w.w = pk2(v1[2], v1[3]); *(u32x4*)(xn + o) = w; }
                    s += (v0[0] * v0[0] + v0[1] * v0[1]) + (v0[2] * v0[2] + v0[3] * v0[3]) + (v1[0] * v1[0] + v1[1] * v1[1]) + (v1[2] * v1[2] + v1[3] * v1[3]);
                }
                s += __shfl_xor(s, 16); s += __shfl_xor(s, 32);
                if (fq == 0) ss[(size_t)row * 16 + u.pn * 4 + wc] = s;
            }
    }
};
template <int ACT> struct EpiScale {
    static constexpr bool PERM = true, AFTER_DRAIN = false;
    bf16_t* O; int ldc; const float* ss; float scale;
    __device__ __forceinline__ void operator()(const f32x4 (&acc)[2][2][4][2], const pg8::Unit& u, int wr, int wc, int fr, int fq) const {
        const int row0 = u.pm * 256 + wr * 64 + fr; const int col0 = u.pn * 256 + wc * 32 + 8 * fq;
#pragma unroll
        for (int ai = 0; ai < 2; ++ai)
#pragma unroll
            for (int m = 0; m < 4; ++m) {
                const int row = row0 + ai * 128 + m * 16;
                const f32x4 s0 = *(const f32x4*)(ss + (size_t)row * 16), s1 = *(const f32x4*)(ss + (size_t)row * 16 + 4), s2 = *(const f32x4*)(ss + (size_t)row * 16 + 8), s3 = *(const f32x4*)(ss + (size_t)row * 16 + 12);
                const f32x4 st = (s0 + s1) + (s2 + s3);
                const float rstd = rsqrtf(((st[0] + st[1]) + (st[2] + st[3])) * (1.f / D) + EPS) * scale;
#pragma unroll
                for (int bj = 0; bj < 2; ++bj) {
                    f32x4 v0 = acc[ai][bj][m][0] * rstd, v1 = acc[ai][bj][m][1] * rstd;
                    if (ACT == 1) {
#pragma unroll
                        for (int j = 0; j < 4; ++j) { const float a = fmaxf(v0[j], 0.f), b = fmaxf(v1[j], 0.f); v0[j] = a * a; v1[j] = b * b; }
                    }
                    u32x4 w; w.x = pk2(v0[0], v0[1]); w.y = pk2(v0[2], v0[3]); w.z = pk2(v1[0], v1[1]); w.w = pk2(v1[2], v1[3]);
                    *(u32x4*)(O + (size_t)row * ldc + col0 + bj * 128) = w;
                }
            }
    }
};

__device__ __forceinline__ void p0_transpose_item(const float* __restrict__ W, int K, int N, bf16_t* WT, int dest_row0, const float* __restrict__ gk, LAS float* scr, int k0, int n0, int lane) {
#pragma unroll 8
    for (int i = 0; i < 32; ++i) { const int kk = 2 * i + (lane >> 5); float v = W[(size_t)(k0 + kk) * N + n0 + (lane & 31)]; if (gk) v *= gk[k0 + kk]; scr[kk * 33 + (lane & 31)] = v; }
    asm volatile("s_waitcnt lgkmcnt(0)" ::: "memory");
    const int c = lane & 7;
#pragma unroll
    for (int j = 0; j < 4; ++j) { const int n = (lane >> 3) + 8 * j; const LAS float* s = scr + (8 * c) * 33 + n;
        u32x4 o; o.x = pk2(s[0 * 33], s[1 * 33]); o.y = pk2(s[2 * 33], s[3 * 33]); o.z = pk2(s[4 * 33], s[5 * 33]); o.w = pk2(s[6 * 33], s[7 * 33]);
        *(u32x4*)(WT + (size_t)(dest_row0 + n) * K + k0 + 8 * c) = o; }
    asm volatile("s_waitcnt lgkmcnt(0)" ::: "memory");
}
__device__ __forceinline__ int win_dest_row(int n0) {
    if (n0 < 1536) return n0;
    const int cc = n0 - 1536, isg = cc >= 512, ch = cc & 511;
    return 1536 + 256 * (ch >> 7) + 128 * isg + (ch & 127);
}
__device__ __forceinline__ void rms_row_to_bf16(const float* xrow, const float* g, bf16_t* orow, int lane) {
    f32x4 v[4]; float s = 0.f;
#pragma unroll
    for (int j = 0; j < 4; ++j) { v[j] = *(const f32x4*)(xrow + 4 * lane + 256 * j); s += (v[j][0] * v[j][0] + v[j][1] * v[j][1]) + (v[j][2] * v[j][2] + v[j][3] * v[j][3]); }
    const float rstd = rsqrtf(wave_sum(s) * (1.f / D) + EPS);
#pragma unroll
    for (int j = 0; j < 4; ++j) { const f32x4 gg = *(const f32x4*)(g + 4 * lane + 256 * j); const f32x4 y = v[j] * rstd * gg;
        u32x2 w; w.x = pk2(y[0], y[1]); w.y = pk2(y[2], y[3]); *(u32x2*)(orow + 4 * lane + 256 * j) = w; }
}
__device__ __forceinline__ void p0_prologue(LAS unsigned char* lds, const Args& a, int tid) {
    const int lane = tid & 63, wave = __builtin_amdgcn_readfirstlane(tid >> 6);
    LAS float* scr = (LAS float*)(lds + wave * 16384);
    const int gw = blockIdx.x * 8 + wave, NGW = gridDim.x * 8;
    unsigned char* ws = a.ws;
    constexpr int I_IN = 16 * 80, I_SQ = 16 * 32, I_UP = 16 * 128, I_DN = 64 * 32;
    constexpr int NITEMS = I_IN + 5 * I_SQ + I_UP + I_DN;
    for (int it = gw; it < NITEMS; it += NGW) {
        int r = it;
        if (r < I_IN) { const int kb = r / 80, nb = r % 80; p0_transpose_item(a.in[3], D, DIN, (bf16_t*)(ws + WS_WIN), win_dest_row(32 * nb), nullptr, scr, 64 * kb, 32 * nb, lane); continue; } r -= I_IN;
        if (r < I_SQ) { p0_transpose_item(a.in[8], D, D, (bf16_t*)(ws + WS_WOUT), 32 * (r % 32), nullptr, scr, 64 * (r / 32), 32 * (r % 32), lane); continue; } r -= I_SQ;
        if (r < I_SQ) { p0_transpose_item(a.in[11], D, D, (bf16_t*)(ws + WS_WXQ), 32 * (r % 32), a.in[9], scr, 64 * (r / 32), 32 * (r % 32), lane); continue; } r -= I_SQ;
        if (r < I_SQ) { p0_transpose_item(a.in[12], D, D, (bf16_t*)(ws + WS_WXKV), 32 * (r % 32), nullptr, scr, 64 * (r / 32), 32 * (r % 32), lane); continue; } r -= I_SQ;
        if (r < I_SQ) { p0_transpose_item(a.in[13], D, D, (bf16_t*)(ws + WS_WXKV), 1024 + 32 * (r % 32), nullptr, scr, 64 * (r / 32), 32 * (r % 32), lane); continue; } r -= I_SQ;
        if (r < I_SQ) { p0_transpose_item(a.in[14], D, D, (bf16_t*)(ws + WS_WXO), 32 * (r % 32), nullptr, scr, 64 * (r / 32), 32 * (r % 32), lane); continue; } r -= I_SQ;
        if (r < I_UP) { p0_transpose_item(a.in[16], D, FF, (bf16_t*)(ws + WS_WUP), 32 * (r % 128), a.in[15], scr, 64 * (r / 128), 32 * (r % 128), lane); continue; } r -= I_UP;
        p0_transpose_item(a.in[17], FF, D, (bf16_t*)(ws + WS_WDN), 32 * (r % 32), nullptr, scr, 64 * (r / 32), 32 * (r % 32), lane);
    }
    for (int m = gw; m < M; m += NGW) rms_row_to_bf16(a.in[0] + (size_t)m * D, a.in[2], (bf16_t*)(ws + WS_XN) + (size_t)m * D, lane);
    for (int m = gw; m < MM; m += NGW) rms_row_to_bf16(a.in[1] + (size_t)m * D, a.in[10], (bf16_t*)(ws + WS_MN) + (size_t)m * D, lane);
    float* CS = (float*)(ws + WS_CS);
    for (int idx = blockIdx.x * 512 + tid; idx < SEQ * 8; idx += gridDim.x * 512) {
        const int pos = idx >> 3, i = idx & 7;
        const float freq = powf(500000.0f, -(float)(2 * i) / 16.0f);
        const float ang = (float)pos * freq;
        CS[2 * idx] = cosf(ang); CS[2 * idx + 1] = sinf(ang);
    }
}

constexpr int KV_ROWS = 272, KV_PITCH = 144, KV_BYTES = KV_ROWS * KV_PITCH;
constexpr int N_DATTN_UNITS = BATCH * 8 * 192;
__device__ __forceinline__ void dattn_unit(LAS unsigned char* lds, const bf16_t* __restrict__ Qb, const bf16_t* __restrict__ Kb, const bf16_t* __restrict__ Vb, bf16_t* OP, float* LSE, int unit, int tid) {
    const int lane = tid & 63, w = __builtin_amdgcn_readfirstlane(tid >> 6), ql = lane & 15, g = lane >> 4;
    const int bh = unit / 192, rem = unit % 192, pat = rem / 64, blk = rem % 64;
    const int b = bh >> 3, h = bh & 7;
    const int dsh = 2 * pat, d = 1 << dsh, L = SEQ >> dsh, nblk = L >> 7;
    const int r = blk / nblk, jb = blk % nblk, j0 = jb * 128;
    const size_t rowbase = (size_t)b * SEQ;
    for (int c = tid; c < 2 * KV_ROWS * 8; c += 512) {
        const int which = c >= KV_ROWS * 8; const int cc = which ? c - KV_ROWS * 8 : c; const int row = cc >> 3, ch = cc & 7; const int j = j0 - 64 + row;
        u32x4 v = {0u, 0u, 0u, 0u};
        if (j >= 0 && j < L) v = *(const u32x4*)((which ? Vb : Kb) + (rowbase + (size_t)j * d + r) * 512 + h * 64 + ch * 8);
        *(LAS u32x4*)(lds + which * KV_BYTES + row * KV_PITCH + ch * 16) = v;
    }
    const int jq = j0 + 16 * w + ql; const size_t qrow = rowbase + (size_t)jq * d + r;
    const bf16_t* qp = Qb + qrow * 512 + h * 64 + 8 * g;
    const bf16x8 qf0 = *(const bf16x8*)qp, qf1 = *(const bf16x8*)(qp + 32);
    __syncthreads();
    f32x4 st[9];
    const LAS unsigned char* kp = lds + (16 * w + ql) * KV_PITCH + g * 16;
#pragma unroll
    for (int t = 0; t < 9; ++t) {
        const bf16x8 k0 = *(const LAS bf16x8*)(kp + t * 16 * KV_PITCH), k1 = *(const LAS bf16x8*)(kp + t * 16 * KV_PITCH + 64);
        f32x4 z = {0.f, 0.f, 0.f, 0.f};
        z = MFMA16(k0, qf0, z); st[t] = MFMA16(k1, qf1, z);
    }
    float mx = -1e30f;
#pragma unroll
    for (int t = 0; t < 9; ++t)
#pragma unroll
        for (int i = 0; i < 4; ++i) {
            const int diff = 16 * t + 4 * g + i - 64 - ql, jk = jq + diff;
            const bool valid = (diff >= -64) && (diff <= 64) && (jk >= 0) && (jk < L);
            const float s = valid ? st[t][i] : -1e30f; st[t][i] = s; mx = fmaxf(mx, s);
        }
    mx = fmaxf(mx, __shfl_xor(mx, 16)); mx = fmaxf(mx, __shfl_xor(mx, 32));
    float lsum = 0.f;
#pragma unroll
    for (int t = 0; t < 9; ++t)
#pragma unroll
        for (int i = 0; i < 4; ++i) { const float p = exp2f(st[t][i] - mx); st[t][i] = p; lsum += p; }
    lsum += __shfl_xor(lsum, 16); lsum += __shfl_xor(lsum, 32);
    bf16x8 pf[5];
#pragma unroll
    for (int s = 0; s < 5; ++s) {
        u32x4 wv; wv.x = pk2(st[2 * s][0], st[2 * s][1]); wv.y = pk2(st[2 * s][2], st[2 * s][3]);
        if (2 * s + 1 < 9) { wv.z = pk2(st[(2 * s + 1) % 9][0], st[(2 * s + 1) % 9][1]); wv.w = pk2(st[(2 * s + 1) % 9][2], st[(2 * s + 1) % 9][3]); } else { wv.z = 0u; wv.w = 0u; }
        pf[s] = __builtin_bit_cast(bf16x8, wv);
    }
    f32x4 o[4];
#pragma unroll
    for (int dt = 0; dt < 4; ++dt) o[dt] = (f32x4){0.f, 0.f, 0.f, 0.f};
    const LAS unsigned char* vp = lds + KV_BYTES + (16 * w + 4 * g + (ql >> 2)) * KV_PITCH + (ql & 3) * 8;
#pragma unroll
    for (int s = 0; s < 5; ++s)
#pragma unroll
        for (int dt = 0; dt < 4; ++dt) {
            const s16x4 lo = vtr(vp + (32 * s) * KV_PITCH + dt * 32), hi = vtr(vp + (32 * s + 16) * KV_PITCH + dt * 32);
            const bf16x8 vf = {lo[0], lo[1], lo[2], lo[3], hi[0], hi[1], hi[2], hi[3]};
            o[dt] = MFMA16(vf, pf[s], o[dt]);
        }
    const float inv = 1.f / lsum;
    bf16_t* op = OP + (size_t)pat * M * 512 + qrow * 512 + h * 64 + 4 * g;
#pragma unroll
    for (int dt = 0; dt < 4; ++dt) { u32x2 wv; wv.x = pk2(o[dt][0] * inv, o[dt][1] * inv); wv.y = pk2(o[dt][2] * inv, o[dt][3] * inv); *(u32x2*)(op + 16 * dt) = wv; }
    if (g == 0) LSE[(size_t)pat * M * 8 + qrow * 8 + h] = mx + log2f(lsum);
    __syncthreads();
}

constexpr int N_CONV_UNITS = M / 32;
__device__ __forceinline__ void conv_unit(LAS unsigned char* lds, const bf16_t* __restrict__ UC, const float* __restrict__ cw, const float* __restrict__ cb, const float* __restrict__ lg, const float* __restrict__ lb, bf16_t* MIX, int unit, int tid) {
    const int p0 = unit * 32, b = p0 >> 13, t0 = p0 & (SEQ - 1);
    LAS unsigned char* ut = lds; LAS float* ot = (LAS float*)(lds + 63488);
    for (int c = tid; c < 62 * 64; c += 512) {
        const int row = c >> 6, ch = c & 63, t = t0 - 15 + row;
        u32x4 v = {0u, 0u, 0u, 0u};
        if (t >= 0 && t < SEQ) v = *(const u32x4*)(UC + ((size_t)b * SEQ + t) * 512 + ch * 8);
        *(LAS u32x4*)(ut + row * 1024 + ch * 16) = v;
    }
    const int cp = tid & 255, half = tid >> 8;
    f32x2 wk[31];
#pragma unroll
    for (int k = 0; k < 31; ++k) wk[k] = *(const f32x2*)(cw + k * 512 + 2 * cp);
    const f32x2 bias = *(const f32x2*)(cb + 2 * cp);
    __syncthreads();
#pragma unroll 1
    for (int grp = 0; grp < 2; ++grp) {
        const int base = half * 16 + grp * 8;
        f32x2 acc[8];
#pragma unroll
        for (int o = 0; o < 8; ++o) acc[o] = bias;
#pragma unroll
        for (int i = 0; i < 38; ++i) {
            const unsigned xw = *(const LAS unsigned*)(ut + (base + i) * 1024 + cp * 4);
            const f32x2 x = {bflo(xw), bfhi(xw)};
#pragma unroll
            for (int o = 0; o < 8; ++o) { const int k = i - o; if (k >= 0 && k <= 30) acc[o] += wk[k < 0 ? 0 : (k > 30 ? 30 : k)] * x; }
        }
#pragma unroll
        for (int o = 0; o < 8; ++o) *(LAS f32x2*)(ot + (base + o) * 512 + 2 * cp) = acc[o];
    }
    __syncthreads();
    const int lane = tid & 63, w = tid >> 6;
    const f32x4 g0 = *(const f32x4*)(lg + 8 * lane), g1 = *(const f32x4*)(lg + 8 * lane + 4), b0 = *(const f32x4*)(lb + 8 * lane), b1 = *(const f32x4*)(lb + 8 * lane + 4);
#pragma unroll
    for (int pp = 0; pp < 4; ++pp) {
        const int pos = 4 * w + pp;
        const f32x4 x0 = *(const LAS f32x4*)(ot + pos * 512 + 8 * lane), x1 = *(const LAS f32x4*)(ot + pos * 512 + 8 * lane + 4);
        float s = (x0[0] + x0[1]) + (x0[2] + x0[3]) + (x1[0] + x1[1]) + (x1[2] + x1[3]);
        float s2 = (x0[0] * x0[0] + x0[1] * x0[1]) + (x0[2] * x0[2] + x0[3] * x0[3]) + (x1[0] * x1[0] + x1[1] * x1[1]) + (x1[2] * x1[2] + x1[3] * x1[3]);
        s = wave_sum(s); s2 = wave_sum(s2);
        const float mean = s * (1.f / 512.f), var = fmaxf(s2 * (1.f / 512.f) - mean * mean, 0.f), rstd = rsqrtf(var + EPS);
        float y[8];
#pragma unroll
        for (int j = 0; j < 4; ++j) { y[j] = (x0[j] - mean) * rstd * g0[j] + b0[j]; y[4 + j] = (x1[j] - mean) * rstd * g1[j] + b1[j]; }
#pragma unroll
        for (int j = 0; j < 8; ++j) y[j] = y[j] / (1.f + __expf(-y[j]));
        u32x4 wv; wv.x = pk2(y[0], y[1]); wv.y = pk2(y[2], y[3]); wv.z = pk2(y[4], y[5]); wv.w = pk2(y[6], y[7]);
        *(u32x4*)(MIX + (size_t)(p0 + pos) * 1024 + 512 + 8 * lane) = wv;
    }
    __syncthreads();
}

__device__ __forceinline__ void merge_phase(const bf16_t* __restrict__ OP, const float* __restrict__ LSE, bf16_t* MIX, int tid) {
    for (int idx = blockIdx.x * 512 + tid; idx < M * 64; idx += gridDim.x * 512) {
        const int row = idx >> 6, hc = idx & 63, h = hc >> 3;
        const float l0 = LSE[(size_t)row * 8 + h], l1 = LSE[(size_t)M * 8 + (size_t)row * 8 + h], l2 = LSE[(size_t)2 * M * 8 + (size_t)row * 8 + h];
        const float mx = fmaxf(l0, fmaxf(l1, l2));
        float w0 = exp2f(l0 - mx), w1 = exp2f(l1 - mx), w2 = exp2f(l2 - mx);
        const float inv = 1.f / (w0 + w1 + w2); w0 *= inv; w1 *= inv; w2 *= inv;
        const u32x4 a0 = *(const u32x4*)(OP + (size_t)row * 512 + hc * 8), a1 = *(const u32x4*)(OP + (size_t)M * 512 + (size_t)row * 512 + hc * 8), a2 = *(const u32x4*)(OP + (size_t)2 * M * 512 + (size_t)row * 512 + hc * 8);
        u32x4 wv;
#pragma unroll
        for (int q = 0; q < 4; ++q) {
            const float lo = w0 * bflo(a0[q]) + w1 * bflo(a1[q]) + w2 * bflo(a2[q]);
            const float hi = w0 * bfhi(a0[q]) + w1 * bfhi(a1[q]) + w2 * bfhi(a2[q]);
            wv[q] = pk2(lo, hi);
        }
        *(u32x4*)(MIX + (size_t)row * 1024 + hc * 8) = wv;
    }
}

constexpr int XP = 528;
constexpr int N_XATTN_UNITS = BATCH * 4 * (SEQ / 256);
__device__ __forceinline__ void xattn_unit(LAS unsigned char* lds, const bf16_t* __restrict__ XQ, const bf16_t* __restrict__ XK, const bf16_t* __restrict__ XV, bf16_t* XO, int unit, int tid) {
    const int lane = tid & 63, w = __builtin_amdgcn_readfirstlane(tid >> 6), ql = lane & 15, g = lane >> 4;
    const int b = unit >> 7, xh = (unit >> 5) & 3, qb = unit & 31;
    for (int c = tid; c < 256 * 32; c += 512) { const int row = c >> 5, ch = c & 31;
        *(LAS u32x4*)(lds + row * XP + ch * 16) = *(const u32x4*)(XK + (size_t)(b * NMEM + row) * 1024 + xh * 256 + ch * 8); }
    const size_t qrow0 = (size_t)b * SEQ + qb * 256 + 32 * w + ql;
    bf16x8 qf[2][8];
#pragma unroll
    for (int qt = 0; qt < 2; ++qt)
#pragma unroll
        for (int ks = 0; ks < 8; ++ks) qf[qt][ks] = *(const bf16x8*)(XQ + (qrow0 + 16 * qt) * 1024 + xh * 256 + 32 * ks + 8 * g);
    __syncthreads();
    f32x4 st[16][2];
    const LAS unsigned char* kp = lds + ql * XP + g * 16;
#pragma unroll
    for (int t = 0; t < 16; ++t) {
        f32x4 z0 = {0.f, 0.f, 0.f, 0.f}, z1 = {0.f, 0.f, 0.f, 0.f};
#pragma unroll
        for (int ks = 0; ks < 8; ++ks) { const bf16x8 kf = *(const LAS bf16x8*)(kp + t * 16 * XP + ks * 64); z0 = MFMA16(kf, qf[0][ks], z0); z1 = MFMA16(kf, qf[1][ks], z1); }
        st[t][0] = z0; st[t][1] = z1;
    }
    float inv[2];
    bf16x8 pf[2][8];
#pragma unroll
    for (int qt = 0; qt < 2; ++qt) {
        float mx = -1e30f;
#pragma unroll
        for (int t = 0; t < 16; ++t)
#pragma unroll
            for (int i = 0; i < 4; ++i) mx = fmaxf(mx, st[t][qt][i]);
        mx = fmaxf(mx, __shfl_xor(mx, 16)); mx = fmaxf(mx, __shfl_xor(mx, 32));
        float lsum = 0.f;
#pragma unroll
        for (int t = 0; t < 16; ++t)
#pragma unroll
            for (int i = 0; i < 4; ++i) { const float p = exp2f(st[t][qt][i] - mx); st[t][qt][i] = p; lsum += p; }
        lsum += __shfl_xor(lsum, 16); lsum += __shfl_xor(lsum, 32);
        inv[qt] = 1.f / lsum;
#pragma unroll
        for (int s = 0; s < 8; ++s) {
            u32x4 wv; wv.x = pk2(st[2 * s][qt][0], st[2 * s][qt][1]); wv.y = pk2(st[2 * s][qt][2], st[2 * s][qt][3]);
            wv.z = pk2(st[2 * s + 1][qt][0], st[2 * s + 1][qt][1]); wv.w = pk2(st[2 * s + 1][qt][2], st[2 * s + 1][qt][3]);
            pf[qt][s] = __builtin_bit_cast(bf16x8, wv);
        }
    }
    __syncthreads();
    for (int c = tid; c < 256 * 32; c += 512) { const int row = c >> 5, ch = c & 31;
        *(LAS u32x4*)(lds + row * XP + ch * 16) = *(const u32x4*)(XV + (size_t)(b * NMEM + row) * 1024 + xh * 256 + ch * 8); }
    __syncthreads();
    const LAS unsigned char* vp = lds + (4 * g + (ql >> 2)) * XP + (ql & 3) * 8;
#pragma unroll
    for (int hf = 0; hf < 2; ++hf) {
        f32x4 o[8][2];
#pragma unroll
        for (int dd = 0; dd < 8; ++dd) { o[dd][0] = (f32x4){0.f, 0.f, 0.f, 0.f}; o[dd][1] = (f32x4){0.f, 0.f, 0.f, 0.f}; }
#pragma unroll
        for (int s = 0; s < 8; ++s)
#pragma unroll
            for (int dd = 0; dd < 8; ++dd) {
                const int dt = hf * 8 + dd;
                const s16x4 lo = vtr(vp + (32 * s) * XP + dt * 32), hi = vtr(vp + (32 * s + 16) * XP + dt * 32);
                const bf16x8 vf = {lo[0], lo[1], lo[2], lo[3], hi[0], hi[1], hi[2], hi[3]};
                o[dd][0] = MFMA16(vf, pf[0][s], o[dd][0]); o[dd][1] = MFMA16(vf, pf[1][s], o[dd][1]);
            }
#pragma unroll
        for (int qt = 0; qt < 2; ++qt)
#pragma unroll
            for (int dd = 0; dd < 8; ++dd) {
                u32x2 wv; wv.x = pk2(o[dd][qt][0] * inv[qt], o[dd][qt][1] * inv[qt]); wv.y = pk2(o[dd][qt][2] * inv[qt], o[dd][qt][3] * inv[qt]);
                *(u32x2*)(XO + (qrow0 + 16 * qt) * 1024 + xh * 256 + 16 * (hf * 8 + dd) + 4 * g) = wv;
            }
    }
    __syncthreads();
}

__device__ __forceinline__ void final_phase(float* out, const float* __restrict__ ss, const float* __restrict__ gfin, int tid) {
    const int lane = tid & 63, wave = tid >> 6;
    for (int row = blockIdx.x * 8 + wave; row < M; row += gridDim.x * 8) {
        float s = ss[(size_t)row * 16 + (lane & 15)];
        s += __shfl_xor(s, 1); s += __shfl_xor(s, 2); s += __shfl_xor(s, 4); s += __shfl_xor(s, 8);
        const float rstd = rsqrtf(s * (1.f / D) + EPS);
#pragma unroll
        for (int j = 0; j < 4; ++j) { float* p = out + (size_t)row * D + 4 * lane + 256 * j; const f32x4 v = *(const f32x4*)p, gg = *(const f32x4*)(gfin + 4 * lane + 256 * j); *(f32x4*)p = v * rstd * gg; }
    }
}

__global__ void __launch_bounds__(512, 2) fwd_megakernel(Args a) {
    extern __shared__ __attribute__((aligned(16))) unsigned char lds_raw[];
    LAS unsigned char* lds = (LAS unsigned char*)lds_raw;
    const int tid = threadIdx.x;
    unsigned char* ws = a.ws;
    const int lo = a.ph_lo, hi = a.ph_hi;
    const int G = gridDim.x, c = blockIdx.x;
    bf16_t* XN = (bf16_t*)(ws + WS_XN);
#define IN(k) (lo <= (k) && (k) < hi)
#define SEAM(k) do { if (IN(k) && IN((k) + 1)) cg::this_grid().sync(); } while (0)

    if (IN(0)) p0_prologue(lds, a, tid);
    SEAM(0);
    if (IN(1)) {
        { pg8::Gemm g{XN, (const bf16_t*)(ws + WS_WIN), M, DIN, D}; pg8::StaticOrder S; S.init(M, DIN, G, c);
          EpiIn E{(bf16_t*)(ws + WS_QB), (bf16_t*)(ws + WS_KB), (bf16_t*)(ws + WS_VB), (bf16_t*)(ws + WS_UC), (const float*)(ws + WS_CS)};
          pg8::gemm_phase<EpiIn, pg8::StaticOrder, true, true>(lds, g, S, E); }
        { const int c2 = (c + G - (640 % G)) % G;
          pg8::Gemm g{(const bf16_t*)(ws + WS_MN), (const bf16_t*)(ws + WS_WXKV), MM, 2048, D}; pg8::StaticOrder S; S.init(MM, 2048, G, c2);
          EpiKV E{(bf16_t*)(ws + WS_XK), (bf16_t*)(ws + WS_XV)};
          pg8::gemm_phase<EpiKV, pg8::StaticOrder, true, true>(lds, g, S, E); }
    }
    SEAM(1);
    if (IN(2)) {
        for (int u = c; u < N_DATTN_UNITS; u += G) dattn_unit(lds, (const bf16_t*)(ws + WS_QB), (const bf16_t*)(ws + WS_KB), (const bf16_t*)(ws + WS_VB), (bf16_t*)(ws + WS_OP), (float*)(ws + WS_LSE), u, tid);
        for (int u = c; u < N_CONV_UNITS; u += G) conv_unit(lds, (const bf16_t*)(ws + WS_UC), a.in[4], a.in[5], a.in[6], a.in[7], (bf16_t*)(ws + WS_MIX), u, tid);
    }
    SEAM(2);
    if (IN(3)) merge_phase((const bf16_t*)(ws + WS_OP), (const float*)(ws + WS_LSE), (bf16_t*)(ws + WS_MIX), tid);
    SEAM(3);
    if (IN(4)) { pg8::Gemm g{(const bf16_t*)(ws + WS_MIX), (const bf16_t*)(ws + WS_WOUT), M, D, D}; pg8::StaticOrder S; S.init(M, D, G, c);
        EpiRes E{a.in[0], a.out, XN, (float*)(ws + WS_SS1)};
        pg8::gemm_phase<EpiRes, pg8::StaticOrder, true, true>(lds, g, S, E); }
    SEAM(4);
    if (IN(5)) { pg8::Gemm g{XN, (const bf16_t*)(ws + WS_WXQ), M, D, D}; pg8::StaticOrder S; S.init(M, D, G, c);
        EpiScale<0> E{(bf16_t*)(ws + WS_XQ), D, (const float*)(ws + WS_SS1), XQSCALE};
        pg8::gemm_phase<EpiScale<0>, pg8::StaticOrder, true, true>(lds, g, S, E); }
    SEAM(5);
    if (IN(6)) { for (int u = c; u < N_XATTN_UNITS; u += G) xattn_unit(lds, (const bf16_t*)(ws + WS_XQ), (const bf16_t*)(ws + WS_XK), (const bf16_t*)(ws + WS_XV), (bf16_t*)(ws + WS_XO), u, tid); }
    SEAM(6);
    if (IN(7)) { pg8::Gemm g{(const bf16_t*)(ws + WS_XO), (const bf16_t*)(ws + WS_WXO), M, D, D}; pg8::StaticOrder S; S.init(M, D, G, c);
        EpiRes E{a.out, a.out, XN, (float*)(ws + WS_SS2)};
        pg8::gemm_phase<EpiRes, pg8::StaticOrder, true, true>(lds, g, S, E); }
    SEAM(7);
    if (IN(8)) { pg8::Gemm g{XN, (const bf16_t*)(ws + WS_WUP), M, FF, D}; pg8::StaticOrder S; S.init(M, FF, G, c);
        EpiScale<1> E{(bf16_t*)(ws + WS_U), FF, (const float*)(ws + WS_SS2), 1.f};
        pg8::gemm_phase<EpiScale<1>, pg8::StaticOrder, true, true>(lds, g, S, E); }
    SEAM(8);
    if (IN(9)) { pg8::Gemm g{(const bf16_t*)(ws + WS_U), (const bf16_t*)(ws + WS_WDN), M, D, FF}; pg8::StaticOrder S; S.init(M, D, G, c);
        EpiRes E{a.out, a.out, nullptr, (float*)(ws + WS_SS3)};
        pg8::gemm_phase<EpiRes, pg8::StaticOrder, true, true>(lds, g, S, E); }
    SEAM(9);
    if (IN(10)) final_phase(a.out, (const float*)(ws + WS_SS3), a.in[18], tid);
#undef IN
#undef SEAM
}

#ifndef MK_SPLIT
#define MK_SPLIT 0
#endif
extern "C" void kernel_launch(void* const* d_in, const int* in_sizes, int n_in, void* d_out, int out_size, void* d_ws, size_t ws_size, hipStream_t stream) {
    static int grid = 0;
    if (grid == 0) {
        int dev = 0, cus = 0, per_cu = 0;
        hipGetDevice(&dev);
        hipDeviceGetAttribute(&cus, hipDeviceAttributeMultiprocessorCount, dev);
        if (hipFuncSetAttribute((const void*)fwd_megakernel, hipFuncAttributeMaxDynamicSharedMemorySize, LDS_BYTES) != hipSuccess) fprintf(stderr, "kernel_launch: hipFuncSetAttribute failed\n");
        if (hipOccupancyMaxActiveBlocksPerMultiprocessor(&per_cu, (const void*)fwd_megakernel, 512, LDS_BYTES) != hipSuccess || per_cu < 1) { fprintf(stderr, "kernel_launch: occupancy query says %d\n", per_cu); per_cu = 1; }
        (void)hipGetLastError();
        grid = cus > 0 ? cus : 256;
        if (n_in != 19 || ws_size < WS_END) fprintf(stderr, "kernel_launch: unexpected n_in %d / ws_size %zu\n", n_in, ws_size);
    }
    Args a{};
    for (int i = 0; i < 19; ++i) a.in[i] = (const float*)d_in[i];
    a.out = (float*)d_out; a.ws = (unsigned char*)d_ws;
#if MK_SPLIT
    for (int p = 0; p < NPH; ++p) { a.ph_lo = p; a.ph_hi = p + 1; hipLaunchKernelGGL(fwd_megakernel, dim3(grid), dim3(512), LDS_BYTES, stream, a); }
#else
    a.ph_lo = 0; a.ph_hi = NPH;
    void* args[] = {&a};
    hipError_t e = hipLaunchCooperativeKernel((const void*)fwd_megakernel, dim3(grid), dim3(512), args, LDS_BYTES, stream);
    if (e != hipSuccess) fprintf(stderr, "kernel_launch: cooperative launch failed: %s (grid %d)\n", hipGetErrorString(e), grid);
#endif
}
```

```cpp
#include <hip/hip_runtime.h>
#include <hip/hip_cooperative_groups.h>
#include <cstdio>
#include <cstdint>
namespace cg = cooperative_groups;
namespace pg8 {
#define PG8_LAS __attribute__((address_space(3)))
typedef unsigned short bf16_t;
typedef short bf16x8 __attribute__((ext_vector_type(8)));
typedef float f32x4 __attribute__((ext_vector_type(4)));
typedef unsigned u32x4 __attribute__((ext_vector_type(4)));
constexpr int BM = 256, BK = 64, HALF = 128, HTB = HALF * BK * 2  , STAGE_BYTES = 8 * HTB, NXCD = 8, WGM = 8;

__host__ __device__ __forceinline__ int lds_byte(int r, int c) { const int st = (r >> 4) * 2 + (c >> 5), rr = r & 15, cc = c & 31, ob = rr * 64 + cc * 2; return st * 1024 + (ob ^ (((ob >> 9) & 1) << 5)); }
__host__ __device__ __forceinline__ void stage_rc(int b, int& R, int& C) { const int st = b / 1024, sb = b % 1024, swz = sb ^ (((sb >> 9) & 1) << 5); R = (st >> 1) * 16 + swz / 64; C = (st & 1) * 32 + (swz % 64) / 2; }
__host__ __device__ __forceinline__ int perm32(int rho) { const int n = rho >> 4, i = rho & 15; return 8 * (i >> 2) + 4 * n + (i & 3); }

struct Unit { int pm, pn; };
struct Gemm { const bf16_t* A; const bf16_t* Bt; int M, N, K; };

struct StaticOrder {
    int nM, nN, nwg, G, c;
    __host__ __device__ void init(int M, int N, int G_, int c_) { nM = M / BM; nN = N / BM; nwg = nM * nN; G = G_; c = c_; }
    __host__ __device__ bool next(int i, Unit& u) const {
        const long L = (long)i * G + c; if (L >= nwg) return false;
        int wgid = (int)L; { const int q = nwg / NXCD, r = nwg % NXCD, xcd = wgid % NXCD, off = wgid / NXCD; wgid = (xcd < r ? xcd * (q + 1) : r * (q + 1) + (xcd - r) * q) + off; }
        const int nig = WGM * nN, gid = wgid / nig, fm = gid * WGM, gsz = (nM - fm) < WGM ? (nM - fm) : WGM;
        u.pm = fm + ((wgid % nig) % gsz); u.pn = (wgid % nig) / gsz; return true;
    }
    __device__ __forceinline__ void a_ready(const Unit&) const {}
    __device__ __forceinline__ void done(const Unit&) const {}
};
__device__ __forceinline__ unsigned cvt_pk_bf16(float lo, float hi) { unsigned r; asm volatile("v_cvt_pk_bf16_f32 %0, %1, %2" : "=v"(r) : "v"(lo), "v"(hi)); return r; }
template <class Epi, class Sched, bool ALIGN_EPI = false, bool SP2 = false>
__device__ __forceinline__ void gemm_phase(PG8_LAS unsigned char* lds, const Gemm g, const Sched& S, const Epi& E) {
    const int tid = threadIdx.x, wid = __builtin_amdgcn_readfirstlane(tid >> 6), lane = tid & 63, wr = wid >> 2, wc = wid & 3, fr = lane & 15, fq = lane >> 4;
    const int K = g.K, nt = K / BK;
    unsigned voffA[2], voffB[2];
#pragma unroll
    for (int i = 0; i < 2; ++i) { int R, C; stage_rc(tid * 16 + i * 8192, R, C); const int Rb = Epi::PERM ? ((R & ~31) + perm32(R & 31)) : R;
        voffA[i] = (unsigned)(R * K + C) * 2u; voffB[i] = (unsigned)(Rb * K + C) * 2u; }
    const size_t kstep = (size_t)(BK * 2);
    const size_t hstep = (size_t)HALF * K * 2;
    const size_t tstep = 2 * hstep;
    const unsigned ldsw = (unsigned)wid * 1024u;
    const int aoff = lds_byte(wr * 64 + fr, fq * 8), boff = lds_byte(wc * 32 + fr, fq * 8);
#define PG8_SA(b, h) (((b) * 2 + (h)) * HTB)
#define PG8_SB(b, h) ((4 + (b) * 2 + (h)) * HTB)
#define PG8_STAGE(bufoff, gbase, voff) do { _Pragma("unroll") for (int _i = 0; _i < 2; ++_i) \
        __builtin_amdgcn_global_load_lds((const unsigned*)((const char*)(gbase) + (voff)[_i]), (PG8_LAS unsigned*)(lds + (bufoff) + ldsw + _i * 8192), 16, 0, 0); } while (0)
#define PG8_LDA(dst, b, h) do { _Pragma("unroll") for (int m = 0; m < 4; ++m) _Pragma("unroll") for (int k = 0; k < 2; ++k) dst[m][k] = *(const PG8_LAS bf16x8*)(lds + PG8_SA(b, h) + aoff + m * 2048 + k * 1024); } while (0)
#define PG8_LDB(dst, b, h) do { _Pragma("unroll") for (int n = 0; n < 2; ++n) _Pragma("unroll") for (int k = 0; k < 2; ++k) dst[n][k] = *(const PG8_LAS bf16x8*)(lds + PG8_SB(b, h) + boff + n * 2048 + k * 1024); } while (0)
#define PG8_MMA(ai, bj, At, Bt) do { __builtin_amdgcn_s_setprio(1); _Pragma("unroll") for (int m = 0; m < 4; ++m) _Pragma("unroll") for (int n = 0; n < 2; ++n) _Pragma("unroll") for (int k = 0; k < 2; ++k) \
        acc[ai][bj][m][n] = __builtin_amdgcn_mfma_f32_16x16x32_bf16(Bt[n][k], At[m][k], acc[ai][bj][m][n], 0, 0, 0); __builtin_amdgcn_s_setprio(0); } while (0)
#define PG8_WAIT_V(n) asm volatile("s_waitcnt vmcnt(" #n ")" ::: "memory")
#define PG8_WAIT_L(n) asm volatile("s_waitcnt lgkmcnt(" #n ")" ::: "memory")
#define PG8_BAR __builtin_amdgcn_s_barrier()
#define PG8_SCHED __builtin_amdgcn_sched_barrier(0)
    Unit cur, nxt; int ui = 0;
    if (!S.next(0, cur)) return;
    f32x4 acc[2][2][4][2];
#pragma unroll
    for (int a = 0; a < 2; ++a)
#pragma unroll
        for (int b = 0; b < 2; ++b)
#pragma unroll
            for (int m = 0; m < 4; ++m)
#pragma unroll
                for (int n = 0; n < 2; ++n) acc[a][b][m][n] = (f32x4){0.f, 0.f, 0.f, 0.f};
    bf16x8 At[4][2], B0[2][2], B1[2][2];
    const char* cA = (const char*)g.A + (size_t)cur.pm * tstep; const char* cB = (const char*)g.Bt + (size_t)cur.pn * tstep;
    S.a_ready(cur);
    if constexpr (SP2) {
        PG8_STAGE(PG8_SB(0, 0), cB, voffB); PG8_STAGE(PG8_SB(0, 1), cB + hstep, voffB); PG8_STAGE(PG8_SA(0, 0), cA, voffA); PG8_STAGE(PG8_SA(0, 1), cA + hstep, voffA);
        if (wr == 1) PG8_BAR;
        PG8_WAIT_V(2); PG8_BAR;
        PG8_STAGE(PG8_SB(1, 0), cB + kstep, voffB); PG8_STAGE(PG8_SA(1, 0), cA + kstep, voffA); PG8_STAGE(PG8_SB(1, 1), cB + hstep + kstep, voffB);
        PG8_WAIT_V(6); PG8_BAR;
    } else {
        PG8_STAGE(PG8_SB(0, 0), cB, voffB); PG8_STAGE(PG8_SA(0, 0), cA, voffA); PG8_STAGE(PG8_SB(0, 1), cB + hstep, voffB); PG8_STAGE(PG8_SA(0, 1), cA + hstep, voffA);
        if (wr == 1) PG8_BAR;
        PG8_WAIT_V(4); PG8_BAR;
        PG8_STAGE(PG8_SB(1, 0), cB + kstep, voffB); PG8_STAGE(PG8_SA(1, 0), cA + kstep, voffA); PG8_STAGE(PG8_SB(1, 1), cB + hstep + kstep, voffB);
        PG8_WAIT_V(6); PG8_BAR;
    }
    for (;;) {
        const bool has_next = S.next(ui + 1, nxt);
        const char* nA = has_next ? (const char*)g.A + (size_t)nxt.pm * tstep : cA; const char* nB = has_next ? (const char*)g.Bt + (size_t)nxt.pn * tstep : cB;
        for (int t = 0; t < nt; t += 2) {
            const bool last = (t == nt - 2);
            const char* a1 = cA + (size_t)(t + 1) * kstep;
            const char* a2 = last ? nA : cA + (size_t)(t + 2) * kstep; const char* b2 = last ? nB : cB + (size_t)(t + 2) * kstep;
            const char* a3 = a2 + kstep; const char* b3 = b2 + kstep;
            if (last && has_next) S.a_ready(nxt);
            if constexpr (SP2) {
            PG8_LDB(B0, 0, 0); PG8_LDB(B1, 0, 1); PG8_SCHED; PG8_LDA(At, 0, 0); PG8_STAGE(PG8_SA(1, 1), a1 + hstep, voffA);
            PG8_WAIT_V(8); PG8_WAIT_L(0); PG8_BAR; PG8_MMA(0, 0, At, B0); PG8_MMA(0, 1, At, B1); PG8_BAR; PG8_SCHED;
            PG8_LDA(At, 0, 1); PG8_STAGE(PG8_SB(0, 0), b2, voffB); PG8_STAGE(PG8_SB(0, 1), b2 + hstep, voffB); PG8_STAGE(PG8_SA(0, 0), a2, voffA);
            PG8_WAIT_V(8); PG8_WAIT_L(0); PG8_BAR; PG8_MMA(1, 0, At, B0); PG8_MMA(1, 1, At, B1); PG8_BAR; PG8_SCHED;
            PG8_LDB(B0, 1, 0); PG8_LDB(B1, 1, 1); PG8_SCHED; PG8_LDA(At, 1, 0); PG8_STAGE(PG8_SA(0, 1), a2 + hstep, voffA);
            PG8_WAIT_V(8); PG8_WAIT_L(0); PG8_BAR; PG8_MMA(0, 0, At, B0); PG8_MMA(0, 1, At, B1); PG8_BAR; PG8_SCHED;
            PG8_LDA(At, 1, 1); PG8_STAGE(PG8_SB(1, 0), b3, voffB); PG8_STAGE(PG8_SB(1, 1), b3 + hstep, voffB); PG8_STAGE(PG8_SA(1, 0), a3, voffA);
            PG8_WAIT_V(8); PG8_WAIT_L(0); PG8_BAR; PG8_MMA(1, 0, At, B0); PG8_MMA(1, 1, At, B1); PG8_BAR; PG8_SCHED;
            } else {
            PG8_LDB(B0, 0, 0); PG8_SCHED; PG8_LDA(At, 0, 0); PG8_STAGE(PG8_SA(1, 1), a1 + hstep, voffA);
            PG8_WAIT_L(8); PG8_BAR; PG8_WAIT_L(0); PG8_MMA(0, 0, At, B0); PG8_BAR; PG8_SCHED;
            PG8_LDB(B1, 0, 1); PG8_STAGE(PG8_SB(0, 0), b2, voffB);
            PG8_BAR; PG8_WAIT_L(0); PG8_MMA(0, 1, At, B1); PG8_BAR;
            PG8_LDA(At, 0, 1); PG8_STAGE(PG8_SA(0, 0), a2, voffA);
            PG8_BAR; PG8_WAIT_L(0); PG8_MMA(1, 0, At, B0); PG8_BAR; PG8_SCHED;
            PG8_STAGE(PG8_SB(0, 1), b2 + hstep, voffB);
            PG8_WAIT_V(6); PG8_BAR; PG8_MMA(1, 1, At, B1); PG8_BAR;
            PG8_LDB(B0, 1, 0); PG8_SCHED; PG8_LDA(At, 1, 0); PG8_STAGE(PG8_SA(0, 1), a2 + hstep, voffA);
            PG8_WAIT_L(8); PG8_BAR; PG8_WAIT_L(0); PG8_MMA(0, 0, At, B0); PG8_BAR; PG8_SCHED;
            PG8_LDB(B1, 1, 1); PG8_STAGE(PG8_SB(1, 0), b3, voffB);
            PG8_BAR; PG8_WAIT_L(0); PG8_MMA(0, 1, At, B1); PG8_BAR;
            PG8_LDA(At, 1, 1); PG8_STAGE(PG8_SA(1, 0), a3, voffA);
            PG8_BAR; PG8_WAIT_L(0); PG8_MMA(1, 0, At, B0); PG8_BAR; PG8_SCHED;
            PG8_STAGE(PG8_SB(1, 1), b3 + hstep, voffB);
            PG8_WAIT_V(6); PG8_BAR; PG8_MMA(1, 1, At, B1); PG8_BAR;
            }
        }
        if constexpr (ALIGN_EPI) { if (wr == 0) PG8_BAR; }
        if constexpr (!Epi::AFTER_DRAIN) { E(acc, cur, wr, wc, fr, fq); S.done(cur); }
        if (!has_next) break;
#pragma unroll
        for (int a = 0; a < 2; ++a)
#pragma unroll
            for (int b = 0; b < 2; ++b)
#pragma unroll
                for (int m = 0; m < 4; ++m)
#pragma unroll
                    for (int n = 0; n < 2; ++n) acc[a][b][m][n] = (f32x4){0.f, 0.f, 0.f, 0.f};
        cur = nxt; cA = nA; cB = nB; ++ui;
        if constexpr (ALIGN_EPI) { if (wr == 1) PG8_BAR; }
    }
    PG8_WAIT_V(0);
    if constexpr (!ALIGN_EPI) { if (wr == 0) PG8_BAR; }
    PG8_BAR;
    if constexpr (Epi::AFTER_DRAIN) { E.fused(acc, cur, wr, wc, fr, fq, lds, wid, lane); S.done(cur); }
#undef PG8_SA
#undef PG8_SB
#undef PG8_STAGE
#undef PG8_LDA
#undef PG8_LDB
#undef PG8_MMA
#undef PG8_WAIT_V
#undef PG8_WAIT_L
#undef PG8_BAR
#undef PG8_SCHED
}
}

constexpr int SEQ = 8192, BATCH = 2, M = BATCH * SEQ, D = 1024, DIN = 2560, FF = 4096, NMEM = 256, MM = BATCH * NMEM;
constexpr float EPS = 1e-6f;
constexpr float LOG2E = 1.4426950408889634f;
constexpr float QSCALE = 0.125f * LOG2E;
constexpr float XQSCALE = 0.0625f * LOG2E;

typedef unsigned short bf16_t;
using pg8::bf16x8; using pg8::f32x4; using pg8::u32x4;
typedef short s16x4 __attribute__((ext_vector_type(4)));
typedef short v4i16_t __attribute__((ext_vector_type(4)));
typedef float f32x2 __attribute__((ext_vector_type(2)));
typedef unsigned u32x2 __attribute__((ext_vector_type(2)));
#define LAS __attribute__((address_space(3)))

constexpr size_t MiB = 1u << 20;
constexpr size_t WS_CS = 1 * MiB, WS_SS1 = 2 * MiB, WS_SS2 = 3 * MiB, WS_SS3 = 4 * MiB, WS_LSE = 5 * MiB, WS_MN = 7 * MiB, WS_XK = 8 * MiB, WS_XV = 9 * MiB;
constexpr size_t WS_WIN = 10 * MiB, WS_WOUT = 15 * MiB, WS_WXQ = 17 * MiB, WS_WXKV = 19 * MiB, WS_WXO = 23 * MiB, WS_WUP = 25 * MiB, WS_WDN = 33 * MiB;
constexpr size_t WS_XN = 42 * MiB, WS_QB = 74 * MiB, WS_KB = 90 * MiB, WS_VB = 106 * MiB, WS_UC = 122 * MiB, WS_MIX = 138 * MiB, WS_OP = 170 * MiB;
constexpr size_t WS_XQ = 74 * MiB, WS_XO = 106 * MiB, WS_U = 74 * MiB, WS_END = 218 * MiB;
constexpr int LDS_BYTES = 147456;
constexpr int NPH = 11;

struct Args { const float* in[19]; float* out; unsigned char* ws; int ph_lo, ph_hi; };

__device__ __forceinline__ unsigned pk2(float lo, float hi) { return pg8::cvt_pk_bf16(lo, hi); }
__device__ __forceinline__ float bflo(unsigned w) { return __uint_as_float(w << 16); }
__device__ __forceinline__ float bfhi(unsigned w) { return __uint_as_float(w & 0xffff0000u); }
__device__ __forceinline__ float wave_sum(float v) {
#pragma unroll
    for (int o = 1; o < 64; o <<= 1) v += __shfl_xor(v, o);
    return v;
}
#define MFMA16(a, b, c) __builtin_amdgcn_mfma_f32_16x16x32_bf16((a), (b), (c), 0, 0, 0)
__device__ __forceinline__ s16x4 vtr(const LAS unsigned char* p) { return __builtin_bit_cast(s16x4, __builtin_amdgcn_ds_read_tr16_b64_v4i16((LAS v4i16_t*)p)); }

struct EpiIn {
    static constexpr bool PERM = true, AFTER_DRAIN = false;
    bf16_t *Qb, *Kb, *Vb, *UC; const float* CS;
    __device__ __forceinline__ void operator()(const f32x4 (&acc)[2][2][4][2], const pg8::Unit& u, int wr, int wc, int fr, int fq) const {
        const int row0 = u.pm * 256 + wr * 64 + fr;
        if (u.pn >= 6) {
            const int ch0 = (u.pn - 6) * 128 + wc * 32 + 8 * fq;
#pragma unroll
            for (int ai = 0; ai < 2; ++ai)
#pragma unroll
                for (int m = 0; m < 4; ++m) {
                    const int row = row0 + ai * 128 + m * 16;
                    float r[8];
#pragma unroll
                    for (int n = 0; n < 2; ++n)
#pragma unroll
                        for (int j = 0; j < 4; ++j) { const float a = acc[ai][0][m][n][j], g = acc[ai][1][m][n][j]; r[4 * n + j] = a * __builtin_amdgcn_rcpf(1.f + __expf(-g)); }
                    u32x4 w; w.x = pk2(r[0], r[1]); w.y = pk2(r[2], r[3]); w.z = pk2(r[4], r[5]); w.w = pk2(r[6], r[7]);
                    *(u32x4*)(UC + (size_t)row * 512 + ch0) = w;
                }
        } else if (u.pn >= 4) {
            const int col0 = (u.pn - 4) * 256 + wc * 32 + 8 * fq;
#pragma unroll
            for (int ai = 0; ai < 2; ++ai)
#pragma unroll
                for (int m = 0; m < 4; ++m) {
                    const int row = row0 + ai * 128 + m * 16;
#pragma unroll
                    for (int bj = 0; bj < 2; ++bj) {
                        const f32x4 v0 = acc[ai][bj][m][0], v1 = acc[ai][bj][m][1];
                        u32x4 w; w.x = pk2(v0[0], v0[1]); w.y = pk2(v0[2], v0[3]); w.z = pk2(v1[0], v1[1]); w.w = pk2(v1[2], v1[3]);
                        *(u32x4*)(Vb + (size_t)row * 512 + col0 + bj * 128) = w;
                    }
                }
        } else {
            bf16_t* dst = (u.pn < 2) ? Qb : Kb; const float sc = (u.pn < 2) ? QSCALE : 1.f;
            const int col0 = (u.pn & 1) * 256 + wc * 32 + 8 * fq;
            const bool rope_wave = (wc & 1) == 0;
            const float sgn = (fq == 0) ? -1.f : 1.f;
#pragma unroll
            for (int ai = 0; ai < 2; ++ai)
#pragma unroll
                for (int m = 0; m < 4; ++m) {
                    const int row = row0 + ai * 128 + m * 16;
                    const int pos = row & (SEQ - 1);
                    f32x4 cs[4];
                    if (rope_wave && fq < 2) {
#pragma unroll
                        for (int q = 0; q < 4; ++q) cs[q] = *(const f32x4*)(CS + (size_t)pos * 16 + 4 * q);
                    }
#pragma unroll
                    for (int bj = 0; bj < 2; ++bj) {
                        float v[8];
#pragma unroll
                        for (int n = 0; n < 2; ++n)
#pragma unroll
                            for (int j = 0; j < 4; ++j) v[4 * n + j] = acc[ai][bj][m][n][j];
                        if (rope_wave) {
#pragma unroll
                            for (int i = 0; i < 8; ++i) {
                                const float p = __shfl_xor(v[i], 16);
                                if (fq < 2) { const float c = cs[i >> 1][2 * (i & 1)], s = cs[i >> 1][2 * (i & 1) + 1]; v[i] = v[i] * c + sgn * p * s; }
                            }
                        }
                        u32x4 w; w.x = pk2(v[0] * sc, v[1] * sc); w.y = pk2(v[2] * sc, v[3] * sc); w.z = pk2(v[4] * sc, v[5] * sc); w.w = pk2(v[6] * sc, v[7] * sc);
                        *(u32x4*)(dst + (size_t)row * 512 + col0 + bj * 128) = w;
                    }
                }
        }
    }
};
struct EpiKV {
    static constexpr bool PERM = true, AFTER_DRAIN = false;
    bf16_t *XK, *XV;
    __device__ __forceinline__ void operator()(const f32x4 (&acc)[2][2][4][2], const pg8::Unit& u, int wr, int wc, int fr, int fq) const {
        const int row0 = u.pm * 256 + wr * 64 + fr;
        bf16_t* dst = (u.pn < 4) ? XK : XV; const int col0 = (u.pn & 3) * 256 + wc * 32 + 8 * fq;
#pragma unroll
        for (int ai = 0; ai < 2; ++ai)
#pragma unroll
            for (int m = 0; m < 4; ++m) {
                const int row = row0 + ai * 128 + m * 16;
#pragma unroll
                for (int bj = 0; bj < 2; ++bj) {
                    const f32x4 v0 = acc[ai][bj][m][0], v1 = acc[ai][bj][m][1];
                    u32x4 w; w.x = pk2(v0[0], v0[1]); w.y = pk2(v0[2], v0[3]); w.z = pk2(v1[0], v1[1]); w.w = pk2(v1[2], v1[3]);
                    *(u32x4*)(dst + (size_t)row * 1024 + col0 + bj * 128) = w;
                }
            }
    }
};
template <bool BASE_BF16, bool OUT_F32, bool OUT_BF16> struct EpiRes {
    static constexpr bool PERM = true, AFTER_DRAIN = false;
    const float* base; const bf16_t* baseb; float* out; bf16_t* xn; float* ss;
    __device__ __forceinline__ void operator()(const f32x4 (&acc)[2][2][4][2], const pg8::Unit& u, int wr, int wc, int fr, int fq) const {
        const int row0 = u.pm * 256 + wr * 64 + fr; const int col0 = u.pn * 256 + wc * 32 + 8 * fq;
#pragma unroll
        for (int ai = 0; ai < 2; ++ai)
#pragma unroll
            for (int m = 0; m < 4; ++m) {
                const int row = row0 + ai * 128 + m * 16;
                float s = 0.f;
#pragma unroll
                for (int bj = 0; bj < 2; ++bj) {
                    const size_t o = (size_t)row * D + col0 + bj * 128;
                    f32x4 b0, b1;
                    if (BASE_BF16) { const u32x4 bw = *(const u32x4*)(baseb + o); b0 = (f32x4){bflo(bw.x), bfhi(bw.x), bflo(bw.y), bfhi(bw.y)}; b1 = (f32x4){bflo(bw.z), bfhi(bw.z), bflo(bw.w), bfhi(bw.w)}; }
                    else { b0 = *(const f32x4*)(base + o); b1 = *(const f32x4*)(base + o + 4); }
                    const f32x4 v0 = acc[ai][bj][m][0] + b0, v1 = acc[ai][bj][m][1] + b1;
                    if (OUT_F32) { *(f32x4*)(out + o) = v0; *(f32x4*)(out + o + 4) = v1; }
                    if (OUT_BF16) { u32x4 w; w.x = pk2(v0[0], v0[1]); w.y = pk2(v0[2], v0[3]); w.z = pk2(v1[0], v1[1]); w.w = pk2(v1[2], v1[3]); *(u32x4*)(xn + o) = w; }
                    s += (v0[0] * v0[0] + v0[1] * v0[1]) + (v0[2] * v0[2] + v0[3] * v0[3]) + (v1[0] * v1[0] + v1[1] * v1[1]) + (v1[2] * v1[2] + v1[3] * v1[3]);
                }
                s += __shfl_xor(s, 16); s += __shfl_xor(s, 32);
                if (fq == 0) ss[(size_t)row * 16 + u.pn * 4 + wc] = s;
            }
    }
};
template <int ACT> struct EpiScale {
    static constexpr bool PERM = true, AFTER_DRAIN = false;
    bf16_t* O; int ldc; const float* ss; float scale;
    __device__ __forceinline__ void operator()(const f32x4 (&acc)[2][2][4][2], const pg8::Unit& u, int wr, int wc, int fr, int fq) const {
        const int row0 = u.pm * 256 + wr * 64 + fr; const int col0 = u.pn * 256 + wc * 32 + 8 * fq;
#pragma unroll
        for (int ai = 0; ai < 2; ++ai)
#pragma unroll
            for (int m = 0; m < 4; ++m) {
                const int row = row0 + ai * 128 + m * 16;
                const f32x4 s0 = *(const f32x4*)(ss + (size_t)row * 16), s1 = *(const f32x4*)(ss + (size_t)row * 16 + 4), s2 = *(const f32x4*)(ss + (size_t)row * 16 + 8), s3 = *(const f32x4*)(ss + (size_t)row * 16 + 12);
                const f32x4 st = (s0 + s1) + (s2 + s3);
                const float rstd = rsqrtf(((st[0] + st[1]) + (st[2] + st[3])) * (1.f / D) + EPS) * scale;
#pragma unroll
                for (int bj = 0; bj < 2; ++bj) {
                    f32x4 v0 = acc[ai][bj][m][0] * rstd, v1 = acc[ai][bj][m][1] * rstd;
                    if (ACT == 1) {
#pragma unroll
                        for (int j = 0; j < 4; ++j) { const float a = fmaxf(v0[j], 0.f), b = fmaxf(v1[j], 0.f); v0[j] = a * a; v1[j] = b * b; }
                    }
                    u32x4 w; w.x = pk2(v0[0], v0[1]); w.y = pk2(v0[2], v0[3]); w.z = pk2(v1[0], v1[1]); w.w = pk2(v1[2], v1[3]);
                    *(u32x4*)(O + (size_t)row * ldc + col0 + bj * 128) = w;
                }
            }
    }
};

__device__ __forceinline__ void p0_transpose_item(const float* __restrict__ W, int K, int N, bf16_t* WT, int dest_row0, const float* __restrict__ gk, LAS float* scr, int k0, int n0, int lane) {
#pragma unroll 8
    for (int i = 0; i < 32; ++i) { const int kk = 2 * i + (lane >> 5); float v = W[(size_t)(k0 + kk) * N + n0 + (lane & 31)]; if (gk) v *= gk[k0 + kk]; scr[kk * 33 + (lane & 31)] = v; }
    asm volatile("s_waitcnt lgkmcnt(0)" ::: "memory");
    const int c = lane & 7;
#pragma unroll
    for (int j = 0; j < 4; ++j) { const int n = (lane >> 3) + 8 * j; const LAS float* s = scr + (8 * c) * 33 + n;
        u32x4 o; o.x = pk2(s[0 * 33], s[1 * 33]); o.y = pk2(s[2 * 33], s[3 * 33]); o.z = pk2(s[4 * 33], s[5 * 33]); o.w = pk2(s[6 * 33], s[7 * 33]);
        *(u32x4*)(WT + (size_t)(dest_row0 + n) * K + k0 + 8 * c) = o; }
    asm volatile("s_waitcnt lgkmcnt(0)" ::: "memory");
}
__device__ __forceinline__ int win_dest_row(int n0) {
    if (n0 < 1536) return n0;
    const int cc = n0 - 1536, isg = cc >= 512, ch = cc & 511;
    return 1536 + 256 * (ch >> 7) + 128 * isg + (ch & 127);
}
__device__ __forceinline__ void rms_row_to_bf16(const float* xrow, const float* g, bf16_t* orow, int lane) {
    f32x4 v[4]; float s = 0.f;
#pragma unroll
    for (int j = 0; j < 4; ++j) { v[j] = *(const f32x4*)(xrow + 4 * lane + 256 * j); s += (v[j][0] * v[j][0] + v[j][1] * v[j][1]) + (v[j][2] * v[j][2] + v[j][3] * v[j][3]); }
    const float rstd = rsqrtf(wave_sum(s) * (1.f / D) + EPS);
#pragma unroll
    for (int j = 0; j < 4; ++j) { const f32x4 gg = *(const f32x4*)(g + 4 * lane + 256 * j); const f32x4 y = v[j] * rstd * gg;
        u32x2 w; w.x = pk2(y[0], y[1]); w.y = pk2(y[2], y[3]); *(u32x2*)(orow + 4 * lane + 256 * j) = w; }
}
__device__ __forceinline__ void p0_prologue(LAS unsigned char* lds, const Args& a, int tid) {
    const int lane = tid & 63, wave = __builtin_amdgcn_readfirstlane(tid >> 6);
    LAS float* scr = (LAS float*)(lds + wave * 16384);
    const int gw = blockIdx.x * 8 + wave, NGW = gridDim.x * 8;
    unsigned char* ws = a.ws;
    constexpr int I_IN = 16 * 80, I_SQ = 16 * 32, I_UP = 16 * 128, I_DN = 64 * 32;
    constexpr int NITEMS = I_IN + 5 * I_SQ + I_UP + I_DN;
    for (int it = gw; it < NITEMS; it += NGW) {
        int r = it;
        if (r < I_IN) { const int kb = r / 80, nb = r % 80; p0_transpose_item(a.in[3], D, DIN, (bf16_t*)(ws + WS_WIN), win_dest_row(32 * nb), nullptr, scr, 64 * kb, 32 * nb, lane); continue; } r -= I_IN;
        if (r < I_SQ) { p0_transpose_item(a.in[8], D, D, (bf16_t*)(ws + WS_WOUT), 32 * (r % 32), nullptr, scr, 64 * (r / 32), 32 * (r % 32), lane); continue; } r -= I_SQ;
        if (r < I_SQ) { p0_transpose_item(a.in[11], D, D, (bf16_t*)(ws + WS_WXQ), 32 * (r % 32), a.in[9], scr, 64 * (r / 32), 32 * (r % 32), lane); continue; } r -= I_SQ;
        if (r < I_SQ) { p0_transpose_item(a.in[12], D, D, (bf16_t*)(ws + WS_WXKV), 32 * (r % 32), nullptr, scr, 64 * (r / 32), 32 * (r % 32), lane); continue; } r -= I_SQ;
        if (r < I_SQ) { p0_transpose_item(a.in[13], D, D, (bf16_t*)(ws + WS_WXKV), 1024 + 32 * (r % 32), nullptr, scr, 64 * (r / 32), 32 * (r % 32), lane); continue; } r -= I_SQ;
        if (r < I_SQ) { p0_transpose_item(a.in[14], D, D, (bf16_t*)(ws + WS_WXO), 32 * (r % 32), nullptr, scr, 64 * (r / 32), 32 * (r % 32), lane); continue; } r -= I_SQ;
        if (r < I_UP) { p0_transpose_item(a.in[16], D, FF, (bf16_t*)(ws + WS_WUP), 32 * (r % 128), a.in[15], scr, 64 * (r / 128), 32 * (r % 128), lane); continue; } r -= I_UP;
        p0_transpose_item(a.in[17], FF, D, (bf16_t*)(ws + WS_WDN), 32 * (r % 32), nullptr, scr, 64 * (r / 32), 32 * (r % 32), lane);
    }
    for (int m = gw; m < M; m += NGW) rms_row_to_bf16(a.in[0] + (size_t)m * D, a.in[2], (bf16_t*)(ws + WS_XN) + (size_t)m * D, lane);
    for (int m = gw; m < MM; m += NGW) rms_row_to_bf16(a.in[1] + (size_t)m * D, a.in[10], (bf16_t*)(ws + WS_MN) + (size_t)m * D, lane);
    float* CS = (float*)(ws + WS_CS);
    for (int idx = blockIdx.x * 512 + tid; idx < SEQ * 8; idx += gridDim.x * 512) {
        const int pos = idx >> 3, i = idx & 7;
        const float freq = powf(500000.0f, -(float)(2 * i) / 16.0f);
        const float ang = (float)pos * freq;
        CS[2 * idx] = cosf(ang); CS[2 * idx + 1] = sinf(ang);
    }
}

constexpr int KV_ROWS = 272, KV_PITCH = 144, KV_BYTES = KV_ROWS * KV_PITCH, KV_CHUNKS = KV_ROWS * 8;
constexpr int N_DATTN_UNITS = BATCH * 8 * 192;
struct DUnit { int h, d, L, r, j0, pat; size_t rowbase; };
__device__ __forceinline__ DUnit dattn_decode(int unit) {
    DUnit u; const int bh = unit / 192, rem = unit % 192, blk = rem % 64; u.pat = rem / 64;
    u.h = bh & 7; u.rowbase = (size_t)(bh >> 3) * SEQ;
    const int dsh = 2 * u.pat; u.d = 1 << dsh; u.L = SEQ >> dsh; const int nblk = u.L >> 7;
    u.r = blk / nblk; u.j0 = (blk % nblk) * 128; return u;
}
__device__ __forceinline__ void dattn_issue(const DUnit& u, const bf16_t* __restrict__ Qb, const bf16_t* __restrict__ Kb, const bf16_t* __restrict__ Vb, u32x4 (&kv)[9], bf16x8& qf0, bf16x8& qf1, int tid, int w, int ql, int g) {
#pragma unroll
    for (int i = 0; i < 9; ++i) {
        const int c = tid + 512 * i; const int which = c >= KV_CHUNKS; const int cc = which ? c - KV_CHUNKS : c; const int row = cc >> 3, ch = cc & 7; const int j = u.j0 - 64 + row;
        u32x4 v = {0u, 0u, 0u, 0u};
        if (c < 2 * KV_CHUNKS && j >= 0 && j < u.L) v = *(const u32x4*)((which ? Vb : Kb) + (u.rowbase + (size_t)j * u.d + u.r) * 512 + u.h * 64 + ch * 8);
        kv[i] = v;
    }
    const size_t qrow = u.rowbase + (size_t)(u.j0 + 16 * w + ql) * u.d + u.r;
    const bf16_t* qp = Qb + qrow * 512 + u.h * 64 + 8 * g;
    qf0 = *(const bf16x8*)qp; qf1 = *(const bf16x8*)(qp + 32);
}
__device__ __forceinline__ void dattn_compute(LAS unsigned char* lds, const DUnit& u, const bf16x8 qf0, const bf16x8 qf1, bf16_t* OP, float* LSE, int w, int ql, int g) {
    const int jq = u.j0 + 16 * w + ql; const size_t qrow = u.rowbase + (size_t)jq * u.d + u.r; const int L = u.L;
    f32x4 st[9];
    const LAS unsigned char* kp = lds + (16 * w + ql) * KV_PITCH + g * 16;
#pragma unroll
    for (int t = 0; t < 9; ++t) {
        const bf16x8 k0 = *(const LAS bf16x8*)(kp + t * 16 * KV_PITCH), k1 = *(const LAS bf16x8*)(kp + t * 16 * KV_PITCH + 64);
        f32x4 z = {0.f, 0.f, 0.f, 0.f};
        z = MFMA16(k0, qf0, z); st[t] = MFMA16(k1, qf1, z);
    }
    float mx = -1e30f;
#pragma unroll
    for (int t = 0; t < 9; ++t)
#pragma unroll
        for (int i = 0; i < 4; ++i) {
            const int diff = 16 * t + 4 * g + i - 64 - ql, jk = jq + diff;
            const bool valid = (diff >= -64) && (diff <= 64) && (jk >= 0) && (jk < L);
            const float s = valid ? st[t][i] : -1e30f; st[t][i] = s; mx = fmaxf(mx, s);
        }
    mx = fmaxf(mx, __shfl_xor(mx, 16)); mx = fmaxf(mx, __shfl_xor(mx, 32));
    float lsum = 0.f;
#pragma unroll
    for (int t = 0; t < 9; ++t)
#pragma unroll
        for (int i = 0; i < 4; ++i) { const float p = __builtin_amdgcn_exp2f(st[t][i] - mx); st[t][i] = p; lsum += p; }
    lsum += __shfl_xor(lsum, 16); lsum += __shfl_xor(lsum, 32);
    bf16x8 pf[5];
#pragma unroll
    for (int s = 0; s < 5; ++s) {
        u32x4 wv; wv.x = pk2(st[2 * s][0], st[2 * s][1]); wv.y = pk2(st[2 * s][2], st[2 * s][3]);
        if (2 * s + 1 < 9) { wv.z = pk2(st[(2 * s + 1) % 9][0], st[(2 * s + 1) % 9][1]); wv.w = pk2(st[(2 * s + 1) % 9][2], st[(2 * s + 1) % 9][3]); } else { wv.z = 0u; wv.w = 0u; }
        pf[s] = __builtin_bit_cast(bf16x8, wv);
    }
    f32x4 o[4];
#pragma unroll
    for (int dt = 0; dt < 4; ++dt) o[dt] = (f32x4){0.f, 0.f, 0.f, 0.f};
    const LAS unsigned char* vp = lds + KV_BYTES + (16 * w + 4 * g + (ql >> 2)) * KV_PITCH + (ql & 3) * 8;
#pragma unroll
    for (int s = 0; s < 5; ++s)
#pragma unroll
        for (int dt = 0; dt < 4; ++dt) {
            const s16x4 lo = vtr(vp + (32 * s) * KV_PITCH + dt * 32), hi = vtr(vp + (32 * s + 16) * KV_PITCH + dt * 32);
            const bf16x8 vf = {lo[0], lo[1], lo[2], lo[3], hi[0], hi[1], hi[2], hi[3]};
            o[dt] = MFMA16(vf, pf[s], o[dt]);
        }
    const float inv = __builtin_amdgcn_rcpf(lsum);
    bf16_t* op = OP + (size_t)u.pat * M * 512 + qrow * 512 + u.h * 64 + 4 * g;
#pragma unroll
    for (int dt = 0; dt < 4; ++dt) { u32x2 wv; wv.x = pk2(o[dt][0] * inv, o[dt][1] * inv); wv.y = pk2(o[dt][2] * inv, o[dt][3] * inv); *(u32x2*)(op + 16 * dt) = wv; }
    if (g == 0) LSE[(size_t)u.pat * M * 8 + qrow * 8 + u.h] = mx + __builtin_amdgcn_logf(lsum);
}
__device__ __forceinline__ void dattn_phase(LAS unsigned char* lds, const bf16_t* __restrict__ Qb, const bf16_t* __restrict__ Kb, const bf16_t* __restrict__ Vb, bf16_t* OP, float* LSE, int c0, int G, int tid) {
    const int lane = tid & 63, w = __builtin_amdgcn_readfirstlane(tid >> 6), ql = lane & 15, g = lane >> 4;
    int un = c0; if (un >= N_DATTN_UNITS) return;
    u32x4 kv[9]; bf16x8 qn0, qn1;
    DUnit cur = dattn_decode(un);
    dattn_issue(cur, Qb, Kb, Vb, kv, qn0, qn1, tid, w, ql, g);
#pragma unroll 1
    for (;;) {
#pragma unroll
        for (int i = 0; i < 9; ++i) {
            const int c = tid + 512 * i; const int which = c >= KV_CHUNKS; const int cc = which ? c - KV_CHUNKS : c; const int row = cc >> 3, ch = cc & 7;
            if (c < 2 * KV_CHUNKS) *(LAS u32x4*)(lds + which * KV_BYTES + row * KV_PITCH + ch * 16) = kv[i];
        }
        const bf16x8 q0 = qn0, q1 = qn1;
        __syncthreads();
        un += G; const bool has = un < N_DATTN_UNITS;
        DUnit nxt = cur;
        if (has) { nxt = dattn_decode(un); dattn_issue(nxt, Qb, Kb, Vb, kv, qn0, qn1, tid, w, ql, g); }
        dattn_compute(lds, cur, q0, q1, OP, LSE, w, ql, g);
        __syncthreads();
        if (!has) break;
        cur = nxt;
    }
}

constexpr int N_CONV_UNITS = M / 32;
__device__ __forceinline__ void conv_unit(LAS unsigned char* lds, const bf16_t* __restrict__ UC, const float* __restrict__ cw, const float* __restrict__ cb, const float* __restrict__ lg, const float* __restrict__ lb, bf16_t* MIX, int unit, int tid) {
    const int p0 = unit * 32, b = p0 >> 13, t0 = p0 & (SEQ - 1);
    LAS unsigned char* ut = lds; LAS float* ot = (LAS float*)(lds + 63488);
    {
        u32x4 tmp[8];
#pragma unroll
        for (int i = 0; i < 8; ++i) { const int c = tid + 512 * i; const int row = c >> 6, ch = c & 63, t = t0 - 15 + row;
            u32x4 v = {0u, 0u, 0u, 0u};
            if (c < 62 * 64 && t >= 0 && t < SEQ) v = *(const u32x4*)(UC + ((size_t)b * SEQ + t) * 512 + ch * 8);
            tmp[i] = v; }
#pragma unroll
        for (int i = 0; i < 8; ++i) { const int c = tid + 512 * i; const int row = c >> 6, ch = c & 63; if (c < 62 * 64) *(LAS u32x4*)(ut + row * 1024 + ch * 16) = tmp[i]; }
    }
    const int cp = tid & 255, half = tid >> 8;
    f32x2 wk[31];
#pragma unroll
    for (int k = 0; k < 31; ++k) wk[k] = *(const f32x2*)(cw + k * 512 + 2 * cp);
    const f32x2 bias = *(const f32x2*)(cb + 2 * cp);
    __syncthreads();
#pragma unroll 1
    for (int grp = 0; grp < 2; ++grp) {
        const int base = half * 16 + grp * 8;
        f32x2 acc[8];
#pragma unroll
        for (int o = 0; o < 8; ++o) acc[o] = bias;
#pragma unroll
        for (int i = 0; i < 38; ++i) {
            const unsigned xw = *(const LAS unsigned*)(ut + (base + i) * 1024 + cp * 4);
            const f32x2 x = {bflo(xw), bfhi(xw)};
#pragma unroll
            for (int o = 0; o < 8; ++o) { const int k = i - o; if (k >= 0 && k <= 30) acc[o] += wk[k < 0 ? 0 : (k > 30 ? 30 : k)] * x; }
        }
#pragma unroll
        for (int o = 0; o < 8; ++o) *(LAS f32x2*)(ot + (base + o) * 512 + 2 * cp) = acc[o];
    }
    __syncthreads();
    const int lane = tid & 63, w = tid >> 6;
    const f32x4 g0 = *(const f32x4*)(lg + 8 * lane), g1 = *(const f32x4*)(lg + 8 * lane + 4), b0 = *(const f32x4*)(lb + 8 * lane), b1 = *(const f32x4*)(lb + 8 * lane + 4);
#pragma unroll
    for (int pp = 0; pp < 4; ++pp) {
        const int pos = 4 * w + pp;
        const f32x4 x0 = *(const LAS f32x4*)(ot + pos * 512 + 8 * lane), x1 = *(const LAS f32x4*)(ot + pos * 512 + 8 * lane + 4);
        float s = (x0[0] + x0[1]) + (x0[2] + x0[3]) + (x1[0] + x1[1]) + (x1[2] + x1[3]);
        float s2 = (x0[0] * x0[0] + x0[1] * x0[1]) + (x0[2] * x0[2] + x0[3] * x0[3]) + (x1[0] * x1[0] + x1[1] * x1[1]) + (x1[2] * x1[2] + x1[3] * x1[3]);
        s = wave_sum(s); s2 = wave_sum(s2);
        const float mean = s * (1.f / 512.f), var = fmaxf(s2 * (1.f / 512.f) - mean * mean, 0.f), rstd = rsqrtf(var + EPS);
        float y[8];
#pragma unroll
        for (int j = 0; j < 4; ++j) { y[j] = (x0[j] - mean) * rstd * g0[j] + b0[j]; y[4 + j] = (x1[j] - mean) * rstd * g1[j] + b1[j]; }
#pragma unroll
        for (int j = 0; j < 8; ++j) y[j] = y[j] * __builtin_amdgcn_rcpf(1.f + __expf(-y[j]));
        u32x4 wv; wv.x = pk2(y[0], y[1]); wv.y = pk2(y[2], y[3]); wv.z = pk2(y[4], y[5]); wv.w = pk2(y[6], y[7]);
        *(u32x4*)(MIX + (size_t)(p0 + pos) * 1024 + 512 + 8 * lane) = wv;
    }
    __syncthreads();
}

__device__ __forceinline__ void merge_phase(const bf16_t* __restrict__ OP, const float* __restrict__ LSE, bf16_t* MIX, int tid) {
    for (int idx = blockIdx.x * 512 + tid; idx < M * 64; idx += gridDim.x * 512) {
        const int row = idx >> 6, hc = idx & 63, h = hc >> 3;
        const float l0 = LSE[(size_t)row * 8 + h], l1 = LSE[(size_t)M * 8 + (size_t)row * 8 + h], l2 = LSE[(size_t)2 * M * 8 + (size_t)row * 8 + h];
        const float mx = fmaxf(l0, fmaxf(l1, l2));
        float w0 = exp2f(l0 - mx), w1 = exp2f(l1 - mx), w2 = exp2f(l2 - mx);
        const float inv = 1.f / (w0 + w1 + w2); w0 *= inv; w1 *= inv; w2 *= inv;
        const u32x4 a0 = *(const u32x4*)(OP + (size_t)row * 512 + hc * 8), a1 = *(const u32x4*)(OP + (size_t)M * 512 + (size_t)row * 512 + hc * 8), a2 = *(const u32x4*)(OP + (size_t)2 * M * 512 + (size_t)row * 512 + hc * 8);
        u32x4 wv;
#pragma unroll
        for (int q = 0; q < 4; ++q) {
            const float lo = w0 * bflo(a0[q]) + w1 * bflo(a1[q]) + w2 * bflo(a2[q]);
            const float hi = w0 * bfhi(a0[q]) + w1 * bfhi(a1[q]) + w2 * bfhi(a2[q]);
            wv[q] = pk2(lo, hi);
        }
        *(u32x4*)(MIX + (size_t)row * 1024 + hc * 8) = wv;
    }
}

constexpr int XP = 528;
constexpr int N_XATTN_UNITS = BATCH * 4 * (SEQ / 256);
__device__ __forceinline__ void xattn_unit(LAS unsigned char* lds, const bf16_t* __restrict__ XQ, const bf16_t* __restrict__ XK, const bf16_t* __restrict__ XV, bf16_t* XO, int unit, int tid) {
    const int lane = tid & 63, w = __builtin_amdgcn_readfirstlane(tid >> 6), ql = lane & 15, g = lane >> 4;
    const int b = unit >> 7, xh = (unit >> 5) & 3, qb = unit & 31;
#pragma unroll 1
    for (int hb = 0; hb < 2; ++hb) {
        u32x4 tmp[8];
#pragma unroll
        for (int i = 0; i < 8; ++i) { const int c = tid + 512 * (8 * hb + i); const int row = c >> 5, ch = c & 31; tmp[i] = *(const u32x4*)(XK + (size_t)(b * NMEM + row) * 1024 + xh * 256 + ch * 8); }
#pragma unroll
        for (int i = 0; i < 8; ++i) { const int c = tid + 512 * (8 * hb + i); const int row = c >> 5, ch = c & 31; *(LAS u32x4*)(lds + row * XP + ch * 16) = tmp[i]; }
    }
    const size_t qrow0 = (size_t)b * SEQ + qb * 256 + 32 * w + ql;
    bf16x8 qf[2][8];
#pragma unroll
    for (int qt = 0; qt < 2; ++qt)
#pragma unroll
        for (int ks = 0; ks < 8; ++ks) qf[qt][ks] = *(const bf16x8*)(XQ + (qrow0 + 16 * qt) * 1024 + xh * 256 + 32 * ks + 8 * g);
    __syncthreads();
    f32x4 st[16][2];
    const LAS unsigned char* kp = lds + ql * XP + g * 16;
#pragma unroll
    for (int t = 0; t < 16; ++t) {
        f32x4 z0 = {0.f, 0.f, 0.f, 0.f}, z1 = {0.f, 0.f, 0.f, 0.f};
#pragma unroll
        for (int ks = 0; ks < 8; ++ks) { const bf16x8 kf = *(const LAS bf16x8*)(kp + t * 16 * XP + ks * 64); z0 = MFMA16(kf, qf[0][ks], z0); z1 = MFMA16(kf, qf[1][ks], z1); }
        st[t][0] = z0; st[t][1] = z1;
    }
    float inv[2];
    bf16x8 pf[2][8];
#pragma unroll
    for (int qt = 0; qt < 2; ++qt) {
        float mx = -1e30f;
#pragma unroll
        for (int t = 0; t < 16; ++t)
#pragma unroll
            for (int i = 0; i < 4; ++i) mx = fmaxf(mx, st[t][qt][i]);
        mx = fmaxf(mx, __shfl_xor(mx, 16)); mx = fmaxf(mx, __shfl_xor(mx, 32));
        float lsum = 0.f;
#pragma unroll
        for (int t = 0; t < 16; ++t)
#pragma unroll
            for (int i = 0; i < 4; ++i) { const float p = __builtin_amdgcn_exp2f(st[t][qt][i] - mx); st[t][qt][i] = p; lsum += p; }
        lsum += __shfl_xor(lsum, 16); lsum += __shfl_xor(lsum, 32);
        inv[qt] = __builtin_amdgcn_rcpf(lsum);
#pragma unroll
        for (int s = 0; s < 8; ++s) {
            u32x4 wv; wv.x = pk2(st[2 * s][qt][0], st[2 * s][qt][1]); wv.y = pk2(st[2 * s][qt][2], st[2 * s][qt][3]);
            wv.z = pk2(st[2 * s + 1][qt][0], st[2 * s + 1][qt][1]); wv.w = pk2(st[2 * s + 1][qt][2], st[2 * s + 1][qt][3]);
            pf[qt][s] = __builtin_bit_cast(bf16x8, wv);
        }
    }
    __syncthreads();
#pragma unroll 1
    for (int hb = 0; hb < 2; ++hb) {
        u32x4 tmp[8];
#pragma unroll
        for (int i = 0; i < 8; ++i) { const int c = tid + 512 * (8 * hb + i); const int row = c >> 5, ch = c & 31; tmp[i] = *(const u32x4*)(XV + (size_t)(b * NMEM + row) * 1024 + xh * 256 + ch * 8); }
#pragma unroll
        for (int i = 0; i < 8; ++i) { const int c = tid + 512 * (8 * hb + i); const int row = c >> 5, ch = c & 31; *(LAS u32x4*)(lds + row * XP + ch * 16) = tmp[i]; }
    }
    __syncthreads();
    const LAS unsigned char* vp = lds + (4 * g + (ql >> 2)) * XP + (ql & 3) * 8;
#pragma unroll
    for (int hf = 0; hf < 2; ++hf) {
        f32x4 o[8][2];
#pragma unroll
        for (int dd = 0; dd < 8; ++dd) { o[dd][0] = (f32x4){0.f, 0.f, 0.f, 0.f}; o[dd][1] = (f32x4){0.f, 0.f, 0.f, 0.f}; }
#pragma unroll
        for (int s = 0; s < 8; ++s)
#pragma unroll
            for (int dd = 0; dd < 8; ++dd) {
                const int dt = hf * 8 + dd;
                const s16x4 lo = vtr(vp + (32 * s) * XP + dt * 32), hi = vtr(vp + (32 * s + 16) * XP + dt * 32);
                const bf16x8 vf = {lo[0], lo[1], lo[2], lo[3], hi[0], hi[1], hi[2], hi[3]};
                o[dd][0] = MFMA16(vf, pf[0][s], o[dd][0]); o[dd][1] = MFMA16(vf, pf[1][s], o[dd][1]);
            }
#pragma unroll
        for (int qt = 0; qt < 2; ++qt)
#pragma unroll
            for (int dd = 0; dd < 8; ++dd) {
                u32x2 wv; wv.x = pk2(o[dd][qt][0] * inv[qt], o[dd][qt][1] * inv[qt]); wv.y = pk2(o[dd][qt][2] * inv[qt], o[dd][qt][3] * inv[qt]);
                *(u32x2*)(XO + (qrow0 + 16 * qt) * 1024 + xh * 256 + 16 * (hf * 8 + dd) + 4 * g) = wv;
            }
    }
    __syncthreads();
}

__device__ __forceinline__ void final_phase(float* out, const float* __restrict__ ss, const float* __restrict__ gfin, int tid) {
    const int lane = tid & 63, wave = tid >> 6;
    for (int row = blockIdx.x * 8 + wave; row < M; row += gridDim.x * 8) {
        float s = ss[(size_t)row * 16 + (lane & 15)];
        s += __shfl_xor(s, 1); s += __shfl_xor(s, 2); s += __shfl_xor(s, 4); s += __shfl_xor(s, 8);
        const float rstd = rsqrtf(s * (1.f / D) + EPS);
#pragma unroll
        for (int j = 0; j < 4; ++j) { float* p = out + (size_t)row * D + 4 * lane + 256 * j; const f32x4 v = *(const f32x4*)p, gg = *(const f32x4*)(gfin + 4 * lane + 256 * j); *(f32x4*)p = v * rstd * gg; }
    }
}

__global__ void __launch_bounds__(512, 2) fwd_megakernel(Args a) {
    extern __shared__ __attribute__((aligned(16))) unsigned char lds_raw[];
    LAS unsigned char* lds = (LAS unsigned char*)lds_raw;
    const int tid = threadIdx.x;
    unsigned char* ws = a.ws;
    const int lo = a.ph_lo, hi = a.ph_hi;
    const int G = gridDim.x, c = blockIdx.x;
    bf16_t* XN = (bf16_t*)(ws + WS_XN);
#define IN(k) (lo <= (k) && (k) < hi)
#define SEAM(k) do { if (IN(k) && IN((k) + 1)) cg::this_grid().sync(); } while (0)

    if (IN(0)) p0_prologue(lds, a, tid);
    SEAM(0);
    if (IN(1)) {
        { pg8::Gemm g{XN, (const bf16_t*)(ws + WS_WIN), M, DIN, D}; pg8::StaticOrder S; S.init(M, DIN, G, c);
          EpiIn E{(bf16_t*)(ws + WS_QB), (bf16_t*)(ws + WS_KB), (bf16_t*)(ws + WS_VB), (bf16_t*)(ws + WS_UC), (const float*)(ws + WS_CS)};
          pg8::gemm_phase<EpiIn, pg8::StaticOrder, true, true>(lds, g, S, E); }
        { const int c2 = (c + G - (640 % G)) % G;
          pg8::Gemm g{(const bf16_t*)(ws + WS_MN), (const bf16_t*)(ws + WS_WXKV), MM, 2048, D}; pg8::StaticOrder S; S.init(MM, 2048, G, c2);
          EpiKV E{(bf16_t*)(ws + WS_XK), (bf16_t*)(ws + WS_XV)};
          pg8::gemm_phase<EpiKV, pg8::StaticOrder, true, true>(lds, g, S, E); }
    }
    SEAM(1);
    if (IN(2)) {
        dattn_phase(lds, (const bf16_t*)(ws + WS_QB), (const bf16_t*)(ws + WS_KB), (const bf16_t*)(ws + WS_VB), (bf16_t*)(ws + WS_OP), (float*)(ws + WS_LSE), c, G, tid);
        for (int u = c; u < N_CONV_UNITS; u += G) conv_unit(lds, (const bf16_t*)(ws + WS_UC), a.in[4], a.in[5], a.in[6], a.in[7], (bf16_t*)(ws + WS_MIX), u, tid);
    }
    SEAM(2);
    if (IN(3)) merge_phase((const bf16_t*)(ws + WS_OP), (const float*)(ws + WS_LSE), (bf16_t*)(ws + WS_MIX), tid);
    SEAM(3);
    if (IN(4)) { pg8::Gemm g{(const bf16_t*)(ws + WS_MIX), (const bf16_t*)(ws + WS_WOUT), M, D, D}; pg8::StaticOrder S; S.init(M, D, G, c);
        EpiRes<false, false, true> E{a.in[0], nullptr, nullptr, XN, (float*)(ws + WS_SS1)};
        pg8::gemm_phase<EpiRes<false, false, true>, pg8::StaticOrder, true, true>(lds, g, S, E); }
    SEAM(4);
    if (IN(5)) { pg8::Gemm g{XN, (const bf16_t*)(ws + WS_WXQ), M, D, D}; pg8::StaticOrder S; S.init(M, D, G, c);
        EpiScale<0> E{(bf16_t*)(ws + WS_XQ), D, (const float*)(ws + WS_SS1), XQSCALE};
        pg8::gemm_phase<EpiScale<0>, pg8::StaticOrder, true, true>(lds, g, S, E); }
    SEAM(5);
    if (IN(6)) { for (int u = c; u < N_XATTN_UNITS; u += G) xattn_unit(lds, (const bf16_t*)(ws + WS_XQ), (const bf16_t*)(ws + WS_XK), (const bf16_t*)(ws + WS_XV), (bf16_t*)(ws + WS_XO), u, tid); }
    SEAM(6);
    if (IN(7)) { pg8::Gemm g{(const bf16_t*)(ws + WS_XO), (const bf16_t*)(ws + WS_WXO), M, D, D}; pg8::StaticOrder S; S.init(M, D, G, c);
        EpiRes<true, false, true> E{nullptr, XN, nullptr, XN, (float*)(ws + WS_SS2)};
        pg8::gemm_phase<EpiRes<true, false, true>, pg8::StaticOrder, true, true>(lds, g, S, E); }
    SEAM(7);
    if (IN(8)) { pg8::Gemm g{XN, (const bf16_t*)(ws + WS_WUP), M, FF, D}; pg8::StaticOrder S; S.init(M, FF, G, c);
        EpiScale<1> E{(bf16_t*)(ws + WS_U), FF, (const float*)(ws + WS_SS2), 1.f};
        pg8::gemm_phase<EpiScale<1>, pg8::StaticOrder, true, true>(lds, g, S, E); }
    SEAM(8);
    if (IN(9)) { pg8::Gemm g{(const bf16_t*)(ws + WS_U), (const bf16_t*)(ws + WS_WDN), M, D, FF}; pg8::StaticOrder S; S.init(M, D, G, c);
        EpiRes<true, true, false> E{nullptr, XN, a.out, nullptr, (float*)(ws + WS_SS3)};
        pg8::gemm_phase<EpiRes<true, true, false>, pg8::StaticOrder, true, true>(lds, g, S, E); }
    SEAM(9);
    if (IN(10)) final_phase(a.out, (const float*)(ws + WS_SS3), a.in[18], tid);
#undef IN
#undef SEAM
}

#ifndef MK_SPLIT
#define MK_SPLIT 0
#endif
extern "C" void kernel_launch(void* const* d_in, const int* in_sizes, int n_in, void* d_out, int out_size, void* d_ws, size_t ws_size, hipStream_t stream) {
    static int grid = 0;
    if (grid == 0) {
        int dev = 0, cus = 0, per_cu = 0;
        hipGetDevice(&dev);
        hipDeviceGetAttribute(&cus, hipDeviceAttributeMultiprocessorCount, dev);
        if (hipFuncSetAttribute((const void*)fwd_megakernel, hipFuncAttributeMaxDynamicSharedMemorySize, LDS_BYTES) != hipSuccess) fprintf(stderr, "kernel_launch: hipFuncSetAttribute failed\n");
        if (hipOccupancyMaxActiveBlocksPerMultiprocessor(&per_cu, (const void*)fwd_megakernel, 512, LDS_BYTES) != hipSuccess || per_cu < 1) { fprintf(stderr, "kernel_launch: occupancy query says %d\n", per_cu); per_cu = 1; }
        (void)hipGetLastError();
        grid = cus > 0 ? cus : 256;
        if (n_in != 19 || ws_size < WS_END) fprintf(stderr, "kernel_launch: unexpected n_in %d / ws_size %zu\n", n_in, ws_size);
    }
    Args a{};
    for (int i = 0; i < 19; ++i) a.in[i] = (const float*)d_in[i];
    a.out = (float*)d_out; a.ws = (unsigned char*)d_ws;
#if MK_SPLIT
    for (int p = 0; p < NPH; ++p) { a.ph_lo = p; a.ph_hi = p + 1; hipLaunchKernelGGL(fwd_megakernel, dim3(grid), dim3(512), LDS_BYTES, stream, a); }
#else
    a.ph_lo = 0; a.ph_hi = NPH;
    void* args[] = {&a};
    hipError_t e = hipLaunchCooperativeKernel((const void*)fwd_megakernel, dim3(grid), dim3(512), args, LDS_BYTES, stream);
    if (e != hipSuccess) fprintf(stderr, "kernel_launch: cooperative launch failed: %s (grid %d)\n", hipGetErrorString(e), grid);
#endif
}
```

```cpp
#include <hip/hip_runtime.h>
#include <hip/hip_cooperative_groups.h>
#include <cstdio>
#include <cstdint>
namespace cg = cooperative_groups;
namespace pg8 {
#define PG8_LAS __attribute__((address_space(3)))
typedef unsigned short bf16_t;
typedef short bf16x8 __attribute__((ext_vector_type(8)));
typedef float f32x4 __attribute__((ext_vector_type(4)));
typedef unsigned u32x4 __attribute__((ext_vector_type(4)));
constexpr int BM = 256, BK = 64, HALF = 128, HTB = HALF * BK * 2  , STAGE_BYTES = 8 * HTB, NXCD = 8, WGM = 8;

__host__ __device__ __forceinline__ int lds_byte(int r, int c) { const int st = (r >> 4) * 2 + (c >> 5), rr = r & 15, cc = c & 31, ob = rr * 64 + cc * 2; return st * 1024 + (ob ^ (((ob >> 9) & 1) << 5)); }
__host__ __device__ __forceinline__ void stage_rc(int b, int& R, int& C) { const int st = b / 1024, sb = b % 1024, swz = sb ^ (((sb >> 9) & 1) << 5); R = (st >> 1) * 16 + swz / 64; C = (st & 1) * 32 + (swz % 64) / 2; }
__host__ __device__ __forceinline__ int perm32(int rho) { const int n = rho >> 4, i = rho & 15; return 8 * (i >> 2) + 4 * n + (i & 3); }

struct Unit { int pm, pn; };
struct Gemm { const bf16_t* A; const bf16_t* Bt; int M, N, K; };

struct StaticOrder {
    int nM, nN, nwg, G, c;
    __host__ __device__ void init(int M, int N, int G_, int c_) { nM = M / BM; nN = N / BM; nwg = nM * nN; G = G_; c = c_; }
    __host__ __device__ bool next(int i, Unit& u) const {
        const long L = (long)i * G + c; if (L >= nwg) return false;
        int wgid = (int)L; { const int q = nwg / NXCD, r = nwg % NXCD, xcd = wgid % NXCD, off = wgid / NXCD; wgid = (xcd < r ? xcd * (q + 1) : r * (q + 1) + (xcd - r) * q) + off; }
        const int nig = WGM * nN, gid = wgid / nig, fm = gid * WGM, gsz = (nM - fm) < WGM ? (nM - fm) : WGM;
        u.pm = fm + ((wgid % nig) % gsz); u.pn = (wgid % nig) / gsz; return true;
    }
    __device__ __forceinline__ void a_ready(const Unit&) const {}
    __device__ __forceinline__ void done(const Unit&) const {}
};
__device__ __forceinline__ unsigned cvt_pk_bf16(float lo, float hi) { unsigned r; asm volatile("v_cvt_pk_bf16_f32 %0, %1, %2" : "=v"(r) : "v"(lo), "v"(hi)); return r; }
template <class Epi, class Sched, bool ALIGN_EPI = false, bool SP2 = false>
__device__ __forceinline__ void gemm_phase(PG8_LAS unsigned char* lds, const Gemm g, const Sched& S, const Epi& E) {
    const int tid = threadIdx.x, wid = __builtin_amdgcn_readfirstlane(tid >> 6), lane = tid & 63, wr = wid >> 2, wc = wid & 3, fr = lane & 15, fq = lane >> 4;
    const int K = g.K, nt = K / BK;
    unsigned voffA[2], voffB[2];
#pragma unroll
    for (int i = 0; i < 2; ++i) { int R, C; stage_rc(tid * 16 + i * 8192, R, C); const int Rb = Epi::PERM ? ((R & ~31) + perm32(R & 31)) : R;
        voffA[i] = (unsigned)(R * K + C) * 2u; voffB[i] = (unsigned)(Rb * K + C) * 2u; }
    const size_t kstep = (size_t)(BK * 2);
    const size_t hstep = (size_t)HALF * K * 2;
    const size_t tstep = 2 * hstep;
    const unsigned ldsw = (unsigned)wid * 1024u;
    const int aoff = lds_byte(wr * 64 + fr, fq * 8), boff = lds_byte(wc * 32 + fr, fq * 8);
#define PG8_SA(b, h) (((b) * 2 + (h)) * HTB)
#define PG8_SB(b, h) ((4 + (b) * 2 + (h)) * HTB)
#define PG8_STAGE(bufoff, gbase, voff) do { _Pragma("unroll") for (int _i = 0; _i < 2; ++_i) \
        __builtin_amdgcn_global_load_lds((const unsigned*)((const char*)(gbase) + (voff)[_i]), (PG8_LAS unsigned*)(lds + (bufoff) + ldsw + _i * 8192), 16, 0, 0); } while (0)
#define PG8_LDA(dst, b, h) do { _Pragma("unroll") for (int m = 0; m < 4; ++m) _Pragma("unroll") for (int k = 0; k < 2; ++k) dst[m][k] = *(const PG8_LAS bf16x8*)(lds + PG8_SA(b, h) + aoff + m * 2048 + k * 1024); } while (0)
#define PG8_LDB(dst, b, h) do { _Pragma("unroll") for (int n = 0; n < 2; ++n) _Pragma("unroll") for (int k = 0; k < 2; ++k) dst[n][k] = *(const PG8_LAS bf16x8*)(lds + PG8_SB(b, h) + boff + n * 2048 + k * 1024); } while (0)
#define PG8_MMA(ai, bj, At, Bt) do { __builtin_amdgcn_s_setprio(1); _Pragma("unroll") for (int m = 0; m < 4; ++m) _Pragma("unroll") for (int n = 0; n < 2; ++n) _Pragma("unroll") for (int k = 0; k < 2; ++k) \
        acc[ai][bj][m][n] = __builtin_amdgcn_mfma_f32_16x16x32_bf16(Bt[n][k], At[m][k], acc[ai][bj][m][n], 0, 0, 0); __builtin_amdgcn_s_setprio(0); } while (0)
#define PG8_WAIT_V(n) asm volatile("s_waitcnt vmcnt(" #n ")" ::: "memory")
#define PG8_WAIT_L(n) asm volatile("s_waitcnt lgkmcnt(" #n ")" ::: "memory")
#define PG8_BAR __builtin_amdgcn_s_barrier()
#define PG8_SCHED __builtin_amdgcn_sched_barrier(0)
    Unit cur, nxt; int ui = 0;
    if (!S.next(0, cur)) return;
    f32x4 acc[2][2][4][2];
#pragma unroll
    for (int a = 0; a < 2; ++a)
#pragma unroll
        for (int b = 0; b < 2; ++b)
#pragma unroll
            for (int m = 0; m < 4; ++m)
#pragma unroll
                for (int n = 0; n < 2; ++n) acc[a][b][m][n] = (f32x4){0.f, 0.f, 0.f, 0.f};
    bf16x8 At[4][2], B0[2][2], B1[2][2];
    const char* cA = (const char*)g.A + (size_t)cur.pm * tstep; const char* cB = (const char*)g.Bt + (size_t)cur.pn * tstep;
    S.a_ready(cur);
    if constexpr (SP2) {
        PG8_STAGE(PG8_SB(0, 0), cB, voffB); PG8_STAGE(PG8_SB(0, 1), cB + hstep, voffB); PG8_STAGE(PG8_SA(0, 0), cA, voffA); PG8_STAGE(PG8_SA(0, 1), cA + hstep, voffA);
        if (wr == 1) PG8_BAR;
        PG8_WAIT_V(2); PG8_BAR;
        PG8_STAGE(PG8_SB(1, 0), cB + kstep, voffB); PG8_STAGE(PG8_SA(1, 0), cA + kstep, voffA); PG8_STAGE(PG8_SB(1, 1), cB + hstep + kstep, voffB);
        PG8_WAIT_V(6); PG8_BAR;
    } else {
        PG8_STAGE(PG8_SB(0, 0), cB, voffB); PG8_STAGE(PG8_SA(0, 0), cA, voffA); PG8_STAGE(PG8_SB(0, 1), cB + hstep, voffB); PG8_STAGE(PG8_SA(0, 1), cA + hstep, voffA);
        if (wr == 1) PG8_BAR;
        PG8_WAIT_V(4); PG8_BAR;
        PG8_STAGE(PG8_SB(1, 0), cB + kstep, voffB); PG8_STAGE(PG8_SA(1, 0), cA + kstep, voffA); PG8_STAGE(PG8_SB(1, 1), cB + hstep + kstep, voffB);
        PG8_WAIT_V(6); PG8_BAR;
    }
    for (;;) {
        const bool has_next = S.next(ui + 1, nxt);
        const char* nA = has_next ? (const char*)g.A + (size_t)nxt.pm * tstep : cA; const char* nB = has_next ? (const char*)g.Bt + (size_t)nxt.pn * tstep : cB;
        for (int t = 0; t < nt; t += 2) {
            const bool last = (t == nt - 2);
            const char* a1 = cA + (size_t)(t + 1) * kstep;
            const char* a2 = last ? nA : cA + (size_t)(t + 2) * kstep; const char* b2 = last ? nB : cB + (size_t)(t + 2) * kstep;
            const char* a3 = a2 + kstep; const char* b3 = b2 + kstep;
            if (last && has_next) S.a_ready(nxt);
            if constexpr (SP2) {
            PG8_LDB(B0, 0, 0); PG8_LDB(B1, 0, 1); PG8_SCHED; PG8_LDA(At, 0, 0); PG8_STAGE(PG8_SA(1, 1), a1 + hstep, voffA);
            PG8_WAIT_V(8); PG8_WAIT_L(0); PG8_BAR; PG8_MMA(0, 0, At, B0); PG8_MMA(0, 1, At, B1); PG8_BAR; PG8_SCHED;
            PG8_LDA(At, 0, 1); PG8_STAGE(PG8_SB(0, 0), b2, voffB); PG8_STAGE(PG8_SB(0, 1), b2 + hstep, voffB); PG8_STAGE(PG8_SA(0, 0), a2, voffA);
            PG8_WAIT_V(8); PG8_WAIT_L(0); PG8_BAR; PG8_MMA(1, 0, At, B0); PG8_MMA(1, 1, At, B1); PG8_BAR; PG8_SCHED;
            PG8_LDB(B0, 1, 0); PG8_LDB(B1, 1, 1); PG8_SCHED; PG8_LDA(At, 1, 0); PG8_STAGE(PG8_SA(0, 1), a2 + hstep, voffA);
            PG8_WAIT_V(8); PG8_WAIT_L(0); PG8_BAR; PG8_MMA(0, 0, At, B0); PG8_MMA(0, 1, At, B1); PG8_BAR; PG8_SCHED;
            PG8_LDA(At, 1, 1); PG8_STAGE(PG8_SB(1, 0), b3, voffB); PG8_STAGE(PG8_SB(1, 1), b3 + hstep, voffB); PG8_STAGE(PG8_SA(1, 0), a3, voffA);
            PG8_WAIT_V(8); PG8_WAIT_L(0); PG8_BAR; PG8_MMA(1, 0, At, B0); PG8_MMA(1, 1, At, B1); PG8_BAR; PG8_SCHED;
            } else {
            PG8_LDB(B0, 0, 0); PG8_SCHED; PG8_LDA(At, 0, 0); PG8_STAGE(PG8_SA(1, 1), a1 + hstep, voffA);
            PG8_WAIT_L(8); PG8_BAR; PG8_WAIT_L(0); PG8_MMA(0, 0, At, B0); PG8_BAR; PG8_SCHED;
            PG8_LDB(B1, 0, 1); PG8_STAGE(PG8_SB(0, 0), b2, voffB);
            PG8_BAR; PG8_WAIT_L(0); PG8_MMA(0, 1, At, B1); PG8_BAR;
            PG8_LDA(At, 0, 1); PG8_STAGE(PG8_SA(0, 0), a2, voffA);
            PG8_BAR; PG8_WAIT_L(0); PG8_MMA(1, 0, At, B0); PG8_BAR; PG8_SCHED;
            PG8_STAGE(PG8_SB(0, 1), b2 + hstep, voffB);
            PG8_WAIT_V(6); PG8_BAR; PG8_MMA(1, 1, At, B1); PG8_BAR;
            PG8_LDB(B0, 1, 0); PG8_SCHED; PG8_LDA(At, 1, 0); PG8_STAGE(PG8_SA(0, 1), a2 + hstep, voffA);
            PG8_WAIT_L(8); PG8_BAR; PG8_WAIT_L(0); PG8_MMA(0, 0, At, B0); PG8_BAR; PG8_SCHED;
            PG8_LDB(B1, 1, 1); PG8_STAGE(PG8_SB(1, 0), b3, voffB);
            PG8_BAR; PG8_WAIT_L(0); PG8_MMA(0, 1, At, B1); PG8_BAR;
            PG8_LDA(At, 1, 1); PG8_STAGE(PG8_SA(1, 0), a3, voffA);
            PG8_BAR; PG8_WAIT_L(0); PG8_MMA(1, 0, At, B0); PG8_BAR; PG8_SCHED;
            PG8_STAGE(PG8_SB(1, 1), b3 + hstep, voffB);
            PG8_WAIT_V(6); PG8_BAR; PG8_MMA(1, 1, At, B1); PG8_BAR;
            }
        }
        if constexpr (ALIGN_EPI) { if (wr == 0) PG8_BAR; }
        if constexpr (!Epi::AFTER_DRAIN) { E(acc, cur, wr, wc, fr, fq); S.done(cur); }
        if (!has_next) break;
#pragma unroll
        for (int a = 0; a < 2; ++a)
#pragma unroll
            for (int b = 0; b < 2; ++b)
#pragma unroll
                for (int m = 0; m < 4; ++m)
#pragma unroll
                    for (int n = 0; n < 2; ++n) acc[a][b][m][n] = (f32x4){0.f, 0.f, 0.f, 0.f};
        cur = nxt; cA = nA; cB = nB; ++ui;
        if constexpr (ALIGN_EPI) { if (wr == 1) PG8_BAR; }
    }
    PG8_WAIT_V(0);
    if constexpr (!ALIGN_EPI) { if (wr == 0) PG8_BAR; }
    PG8_BAR;
    if constexpr (Epi::AFTER_DRAIN) { E.fused(acc, cur, wr, wc, fr, fq, lds, wid, lane); S.done(cur); }
#undef PG8_SA
#undef PG8_SB
#undef PG8_STAGE
#undef PG8_LDA
#undef PG8_LDB
#undef PG8_MMA
#undef PG8_WAIT_V
#undef PG8_WAIT_L
#undef PG8_BAR
#undef PG8_SCHED
}
}

constexpr int SEQ = 8192, BATCH = 2, M = BATCH * SEQ, D = 1024, DIN = 2560, FF = 4096, NMEM = 256, MM = BATCH * NMEM;
constexpr float EPS = 1e-6f;
constexpr float LOG2E = 1.4426950408889634f;
constexpr float QSCALE = 0.125f * LOG2E;
constexpr float XQSCALE = 0.0625f * LOG2E;

typedef unsigned short bf16_t;
using pg8::bf16x8; using pg8::f32x4; using pg8::u32x4;
typedef short s16x4 __attribute__((ext_vector_type(4)));
typedef short v4i16_t __attribute__((ext_vector_type(4)));
typedef float f32x2 __attribute__((ext_vector_type(2)));
typedef unsigned u32x2 __attribute__((ext_vector_type(2)));
#define LAS __attribute__((address_space(3)))

constexpr size_t MiB = 1u << 20;
constexpr size_t WS_CS = 1 * MiB, WS_SS1 = 2 * MiB, WS_SS2 = 3 * MiB, WS_SS3 = 4 * MiB, WS_LSE = 5 * MiB, WS_MN = 7 * MiB, WS_XK = 8 * MiB, WS_XV = 9 * MiB;
constexpr size_t WS_WIN = 10 * MiB, WS_WOUT = 15 * MiB, WS_WXQ = 17 * MiB, WS_WXKV = 19 * MiB, WS_WXO = 23 * MiB, WS_WUP = 25 * MiB, WS_WDN = 33 * MiB;
constexpr size_t WS_XN = 42 * MiB, WS_QB = 74 * MiB, WS_KB = 90 * MiB, WS_VB = 106 * MiB, WS_UC = 122 * MiB, WS_MIX = 138 * MiB, WS_OP = 170 * MiB;
constexpr size_t WS_XQ = 74 * MiB, WS_XO = 106 * MiB, WS_U = 74 * MiB, WS_END = 218 * MiB;
constexpr int LDS_BYTES = 147456;
constexpr int NPH = 11;

struct Args { const float* in[19]; float* out; unsigned char* ws; int ph_lo, ph_hi; };

__device__ __forceinline__ unsigned pk2(float lo, float hi) { return pg8::cvt_pk_bf16(lo, hi); }
__device__ __forceinline__ float bflo(unsigned w) { return __uint_as_float(w << 16); }
__device__ __forceinline__ float bfhi(unsigned w) { return __uint_as_float(w & 0xffff0000u); }
__device__ __forceinline__ float wave_sum(float v) {
#pragma unroll
    for (int o = 1; o < 64; o <<= 1) v += __shfl_xor(v, o);
    return v;
}
#define MFMA16(a, b, c) __builtin_amdgcn_mfma_f32_16x16x32_bf16((a), (b), (c), 0, 0, 0)
__device__ __forceinline__ s16x4 vtr(const LAS unsigned char* p) { return __builtin_bit_cast(s16x4, __builtin_amdgcn_ds_read_tr16_b64_v4i16((LAS v4i16_t*)p)); }

struct EpiIn {
    static constexpr bool PERM = true, AFTER_DRAIN = false;
    bf16_t *Qb, *Kb, *Vb, *UC; const float* CS;
    __device__ __forceinline__ void operator()(const f32x4 (&acc)[2][2][4][2], const pg8::Unit& u, int wr, int wc, int fr, int fq) const {
        const int row0 = u.pm * 256 + wr * 64 + fr;
        if (u.pn >= 6) {
            const int ch0 = (u.pn - 6) * 128 + wc * 32 + 8 * fq;
#pragma unroll
            for (int ai = 0; ai < 2; ++ai)
#pragma unroll
                for (int m = 0; m < 4; ++m) {
                    const int row = row0 + ai * 128 + m * 16;
                    float r[8];
#pragma unroll
                    for (int n = 0; n < 2; ++n)
#pragma unroll
                        for (int j = 0; j < 4; ++j) { const float a = acc[ai][0][m][n][j], g = acc[ai][1][m][n][j]; r[4 * n + j] = a * __builtin_amdgcn_rcpf(1.f + __expf(-g)); }
                    u32x4 w; w.x = pk2(r[0], r[1]); w.y = pk2(r[2], r[3]); w.z = pk2(r[4], r[5]); w.w = pk2(r[6], r[7]);
                    *(u32x4*)(UC + (size_t)row * 512 + ch0) = w;
                }
        } else if (u.pn >= 4) {
            const int col0 = (u.pn - 4) * 256 + wc * 32 + 8 * fq;
#pragma unroll
            for (int ai = 0; ai < 2; ++ai)
#pragma unroll
                for (int m = 0; m < 4; ++m) {
                    const int row = row0 + ai * 128 + m * 16;
#pragma unroll
                    for (int bj = 0; bj < 2; ++bj) {
                        const f32x4 v0 = acc[ai][bj][m][0], v1 = acc[ai][bj][m][1];
                        u32x4 w; w.x = pk2(v0[0], v0[1]); w.y = pk2(v0[2], v0[3]); w.z = pk2(v1[0], v1[1]); w.w = pk2(v1[2], v1[3]);
                        *(u32x4*)(Vb + (size_t)row * 512 + col0 + bj * 128) = w;
                    }
                }
        } else {
            bf16_t* dst = (u.pn < 2) ? Qb : Kb; const float sc = (u.pn < 2) ? QSCALE : 1.f;
            const int col0 = (u.pn & 1) * 256 + wc * 32 + 8 * fq;
            const bool rope_wave = (wc & 1) == 0;
            const float sgn = (fq == 0) ? -1.f : 1.f;
#pragma unroll
            for (int ai = 0; ai < 2; ++ai)
#pragma unroll
                for (int m = 0; m < 4; ++m) {
                    const int row = row0 + ai * 128 + m * 16;
                    const int pos = row & (SEQ - 1);
                    f32x4 cs[4];
                    if (rope_wave && fq < 2) {
#pragma unroll
                        for (int q = 0; q < 4; ++q) cs[q] = *(const f32x4*)(CS + (size_t)pos * 16 + 4 * q);
                    }
#pragma unroll
                    for (int bj = 0; bj < 2; ++bj) {
                        float v[8];
#pragma unroll
                        for (int n = 0; n < 2; ++n)
#pragma unroll
                            for (int j = 0; j < 4; ++j) v[4 * n + j] = acc[ai][bj][m][n][j];
                        if (rope_wave) {
#pragma unroll
                            for (int i = 0; i < 8; ++i) {
                                const float p = __shfl_xor(v[i], 16);
                                if (fq < 2) { const float c = cs[i >> 1][2 * (i & 1)], s = cs[i >> 1][2 * (i & 1) + 1]; v[i] = v[i] * c + sgn * p * s; }
                            }
                        }
                        u32x4 w; w.x = pk2(v[0] * sc, v[1] * sc); w.y = pk2(v[2] * sc, v[3] * sc); w.z = pk2(v[4] * sc, v[5] * sc); w.w = pk2(v[6] * sc, v[7] * sc);
                        *(u32x4*)(dst + (size_t)row * 512 + col0 + bj * 128) = w;
                    }
                }
        }
    }
};
struct EpiKV {
    static constexpr bool PERM = true, AFTER_DRAIN = false;
    bf16_t *XK, *XV;
    __device__ __forceinline__ void operator()(const f32x4 (&acc)[2][2][4][2], const pg8::Unit& u, int wr, int wc, int fr, int fq) const {
        const int row0 = u.pm * 256 + wr * 64 + fr;
        bf16_t* dst = (u.pn < 4) ? XK : XV; const int col0 = (u.pn & 3) * 256 + wc * 32 + 8 * fq;
#pragma unroll
        for (int ai = 0; ai < 2; ++ai)
#pragma unroll
            for (int m = 0; m < 4; ++m) {
                const int row = row0 + ai * 128 + m * 16;
#pragma unroll
                for (int bj = 0; bj < 2; ++bj) {
                    const f32x4 v0 = acc[ai][bj][m][0], v1 = acc[ai][bj][m][1];
                    u32x4 w; w.x = pk2(v0[0], v0[1]); w.y = pk2(v0[2], v0[3]); w.z = pk2(v1[0], v1[1]); w.w = pk2(v1[2], v1[3]);
                    *(u32x4*)(dst + (size_t)row * 1024 + col0 + bj * 128) = w;
                }
            }
    }
};
template <bool BASE_BF16, bool OUT_F32, bool OUT_BF16> struct EpiRes {
    static constexpr bool PERM = true, AFTER_DRAIN = false;
    const float* base; const bf16_t* baseb; float* out; bf16_t* xn; float* ss;
    __device__ __forceinline__ void operator()(const f32x4 (&acc)[2][2][4][2], const pg8::Unit& u, int wr, int wc, int fr, int fq) const {
        const int row0 = u.pm * 256 + wr * 64 + fr; const int col0 = u.pn * 256 + wc * 32 + 8 * fq;
#pragma unroll
        for (int ai = 0; ai < 2; ++ai)
#pragma unroll
            for (int m = 0; m < 4; ++m) {
                const int row = row0 + ai * 128 + m * 16;
                float s = 0.f;
#pragma unroll
                for (int bj = 0; bj < 2; ++bj) {
                    const size_t o = (size_t)row * D + col0 + bj * 128;
                    f32x4 b0, b1;
                    if (BASE_BF16) { const u32x4 bw = *(const u32x4*)(baseb + o); b0 = (f32x4){bflo(bw.x), bfhi(bw.x), bflo(bw.y), bfhi(bw.y)}; b1 = (f32x4){bflo(bw.z), bfhi(bw.z), bflo(bw.w), bfhi(bw.w)}; }
                    else { b0 = *(const f32x4*)(base + o); b1 = *(const f32x4*)(base + o + 4); }
                    const f32x4 v0 = acc[ai][bj][m][0] + b0, v1 = acc[ai][bj][m][1] + b1;
                    if (OUT_F32) { *(f32x4*)(out + o) = v0; *(f32x4*)(out + o + 4) = v1; }
                    if (OUT_BF16) { u32x4 w; w.x = pk2(v0[0], v0[1]); w.y = pk2(v0[2], v0[3]); w.z = pk2(v1[0], v1[1]); w.w = pk2(v1[2], v1[3]); *(u32x4*)(xn + o) = w; }
                    s += (v0[0] * v0[0] + v0[1] * v0[1]) + (v0[2] * v0[2] + v0[3] * v0[3]) + (v1[0] * v1[0] + v1[1] * v1[1]) + (v1[2] * v1[2] + v1[3] * v1[3]);
                }
                s += __shfl_xor(s, 16); s += __shfl_xor(s, 32);
                if (fq == 0) ss[(size_t)row * 16 + u.pn * 4 + wc] = s;
            }
    }
};
template <int ACT> struct EpiScale {
    static constexpr bool PERM = true, AFTER_DRAIN = false;
    bf16_t* O; int ldc; const float* ss; float scale;
    __device__ __forceinline__ void operator()(const f32x4 (&acc)[2][2][4][2], const pg8::Unit& u, int wr, int wc, int fr, int fq) const {
        const int row0 = u.pm * 256 + wr * 64 + fr; const int col0 = u.pn * 256 + wc * 32 + 8 * fq;
#pragma unroll
        for (int ai = 0; ai < 2; ++ai)
#pragma unroll
            for (int m = 0; m < 4; ++m) {
                const int row = row0 + ai * 128 + m * 16;
                const f32x4 s0 = *(const f32x4*)(ss + (size_t)row * 16), s1 = *(const f32x4*)(ss + (size_t)row * 16 + 4), s2 = *(const f32x4*)(ss + (size_t)row * 16 + 8), s3 = *(const f32x4*)(ss + (size_t)row * 16 + 12);
                const f32x4 st = (s0 + s1) + (s2 + s3);
                const float rstd = rsqrtf(((st[0] + st[1]) + (st[2] + st[3])) * (1.f / D) + EPS) * scale;
#pragma unroll
                for (int bj = 0; bj < 2; ++bj) {
                    f32x4 v0 = acc[ai][bj][m][0] * rstd, v1 = acc[ai][bj][m][1] * rstd;
                    if (ACT == 1) {
#pragma unroll
                        for (int j = 0; j < 4; ++j) { const float a = fmaxf(v0[j], 0.f), b = fmaxf(v1[j], 0.f); v0[j] = a * a; v1[j] = b * b; }
                    }
                    u32x4 w; w.x = pk2(v0[0], v0[1]); w.y = pk2(v0[2], v0[3]); w.z = pk2(v1[0], v1[1]); w.w = pk2(v1[2], v1[3]);
                    *(u32x4*)(O + (size_t)row * ldc + col0 + bj * 128) = w;
                }
            }
    }
};

__device__ __forceinline__ void p0_transpose_item(const float* __restrict__ W, int K, int N, bf16_t* WT, int dest_row0, const float* __restrict__ gk, LAS float* scr, int k0, int n0, int lane) {
#pragma unroll 8
    for (int i = 0; i < 32; ++i) { const int kk = 2 * i + (lane >> 5); float v = W[(size_t)(k0 + kk) * N + n0 + (lane & 31)]; if (gk) v *= gk[k0 + kk]; scr[kk * 33 + (lane & 31)] = v; }
    asm volatile("s_waitcnt lgkmcnt(0)" ::: "memory");
    const int c = lane & 7;
#pragma unroll
    for (int j = 0; j < 4; ++j) { const int n = (lane >> 3) + 8 * j; const LAS float* s = scr + (8 * c) * 33 + n;
        u32x4 o; o.x = pk2(s[0 * 33], s[1 * 33]); o.y = pk2(s[2 * 33], s[3 * 33]); o.z = pk2(s[4 * 33], s[5 * 33]); o.w = pk2(s[6 * 33], s[7 * 33]);
        *(u32x4*)(WT + (size_t)(dest_row0 + n) * K + k0 + 8 * c) = o; }
    asm volatile("s_waitcnt lgkmcnt(0)" ::: "memory");
}
__device__ __forceinline__ int win_dest_row(int n0) {
    if (n0 < 1536) return n0;
    const int cc = n0 - 1536, isg = cc >= 512, ch = cc & 511;
    return 1536 + 256 * (ch >> 7) + 128 * isg + (ch & 127);
}
__device__ __forceinline__ void rms_row_to_bf16(const float* xrow, const float* g, bf16_t* orow, int lane) {
    f32x4 v[4]; float s = 0.f;
#pragma unroll
    for (int j = 0; j < 4; ++j) { v[j] = *(const f32x4*)(xrow + 4 * lane + 256 * j); s += (v[j][0] * v[j][0] + v[j][1] * v[j][1]) + (v[j][2] * v[j][2] + v[j][3] * v[j][3]); }
    const float rstd = rsqrtf(wave_sum(s) * (1.f / D) + EPS);
#pragma unroll
    for (int j = 0; j < 4; ++j) { const f32x4 gg = *(const f32x4*)(g + 4 * lane + 256 * j); const f32x4 y = v[j] * rstd * gg;
        u32x2 w; w.x = pk2(y[0], y[1]); w.y = pk2(y[2], y[3]); *(u32x2*)(orow + 4 * lane + 256 * j) = w; }
}
__device__ __forceinline__ void p0_prologue(LAS unsigned char* lds, const Args& a, int tid) {
    const int lane = tid & 63, wave = __builtin_amdgcn_readfirstlane(tid >> 6);
    LAS float* scr = (LAS float*)(lds + wave * 16384);
    const int gw = blockIdx.x * 8 + wave, NGW = gridDim.x * 8;
    unsigned char* ws = a.ws;
    constexpr int I_IN = 16 * 80, I_SQ = 16 * 32, I_UP = 16 * 128, I_DN = 64 * 32;
    constexpr int NITEMS = I_IN + 5 * I_SQ + I_UP + I_DN;
    for (int it = gw; it < NITEMS; it += NGW) {
        int r = it;
        if (r < I_IN) { const int kb = r / 80, nb = r % 80; p0_transpose_item(a.in[3], D, DIN, (bf16_t*)(ws + WS_WIN), win_dest_row(32 * nb), nullptr, scr, 64 * kb, 32 * nb, lane); continue; } r -= I_IN;
        if (r < I_SQ) { p0_transpose_item(a.in[8], D, D, (bf16_t*)(ws + WS_WOUT), 32 * (r % 32), nullptr, scr, 64 * (r / 32), 32 * (r % 32), lane); continue; } r -= I_SQ;
        if (r < I_SQ) { p0_transpose_item(a.in[11], D, D, (bf16_t*)(ws + WS_WXQ), 32 * (r % 32), a.in[9], scr, 64 * (r / 32), 32 * (r % 32), lane); continue; } r -= I_SQ;
        if (r < I_SQ) { p0_transpose_item(a.in[12], D, D, (bf16_t*)(ws + WS_WXKV), 32 * (r % 32), nullptr, scr, 64 * (r / 32), 32 * (r % 32), lane); continue; } r -= I_SQ;
        if (r < I_SQ) { p0_transpose_item(a.in[13], D, D, (bf16_t*)(ws + WS_WXKV), 1024 + 32 * (r % 32), nullptr, scr, 64 * (r / 32), 32 * (r % 32), lane); continue; } r -= I_SQ;
        if (r < I_SQ) { p0_transpose_item(a.in[14], D, D, (bf16_t*)(ws + WS_WXO), 32 * (r % 32), nullptr, scr, 64 * (r / 32), 32 * (r % 32), lane); continue; } r -= I_SQ;
        if (r < I_UP) { p0_transpose_item(a.in[16], D, FF, (bf16_t*)(ws + WS_WUP), 32 * (r % 128), a.in[15], scr, 64 * (r / 128), 32 * (r % 128), lane); continue; } r -= I_UP;
        p0_transpose_item(a.in[17], FF, D, (bf16_t*)(ws + WS_WDN), 32 * (r % 32), nullptr, scr, 64 * (r / 32), 32 * (r % 32), lane);
    }
    for (int m = gw; m < M; m += NGW) rms_row_to_bf16(a.in[0] + (size_t)m * D, a.in[2], (bf16_t*)(ws + WS_XN) + (size_t)m * D, lane);
    for (int m = gw; m < MM; m += NGW) rms_row_to_bf16(a.in[1] + (size_t)m * D, a.in[10], (bf16_t*)(ws + WS_MN) + (size_t)m * D, lane);
    float* CS = (float*)(ws + WS_CS);
    for (int idx = blockIdx.x * 512 + tid; idx < SEQ * 8; idx += gridDim.x * 512) {
        const int pos = idx >> 3, i = idx & 7;
        const float freq = powf(500000.0f, -(float)(2 * i) / 16.0f);
        const float ang = (float)pos * freq;
        CS[2 * idx] = cosf(ang); CS[2 * idx + 1] = sinf(ang);
    }
}

constexpr int KV_ROWS = 272, KV_PITCH = 144, KV_BYTES = KV_ROWS * KV_PITCH, KV_CHUNKS = KV_ROWS * 8;
constexpr int N_DATTN_UNITS = BATCH * 8 * 192;
struct DUnit { int h, d, L, r, j0, pat; size_t rowbase; };
__device__ __forceinline__ DUnit dattn_decode(int unit) {
    DUnit u; const int bh = unit / 192, rem = unit % 192, blk = rem % 64; u.pat = rem / 64;
    u.h = bh & 7; u.rowbase = (size_t)(bh >> 3) * SEQ;
    const int dsh = 2 * u.pat; u.d = 1 << dsh; u.L = SEQ >> dsh; const int nblk = u.L >> 7;
    u.r = blk / nblk; u.j0 = (blk % nblk) * 128; return u;
}
__device__ __forceinline__ void dattn_issue(const DUnit& u, const bf16_t* __restrict__ Qb, const bf16_t* __restrict__ Kb, const bf16_t* __restrict__ Vb, u32x4 (&kv)[9], bf16x8& qf0, bf16x8& qf1, int tid, int w, int ql, int g) {
#pragma unroll
    for (int i = 0; i < 9; ++i) {
        const int c = tid + 512 * i; const int which = c >= KV_CHUNKS; const int cc = which ? c - KV_CHUNKS : c; const int row = cc >> 3, ch = cc & 7; const int j = u.j0 - 64 + row;
        u32x4 v = {0u, 0u, 0u, 0u};
        if (c < 2 * KV_CHUNKS && j >= 0 && j < u.L) v = *(const u32x4*)((which ? Vb : Kb) + (u.rowbase + (size_t)j * u.d + u.r) * 512 + u.h * 64 + ch * 8);
        kv[i] = v;
    }
    const size_t qrow = u.rowbase + (size_t)(u.j0 + 16 * w + ql) * u.d + u.r;
    const bf16_t* qp = Qb + qrow * 512 + u.h * 64 + 8 * g;
    qf0 = *(const bf16x8*)qp; qf1 = *(const bf16x8*)(qp + 32);
}
__device__ __forceinline__ void dattn_compute(LAS unsigned char* lds, const DUnit& u, const bf16x8 qf0, const bf16x8 qf1, bf16_t* OP, float* LSE, int w, int ql, int g) {
    const int jq = u.j0 + 16 * w + ql; const size_t qrow = u.rowbase + (size_t)jq * u.d + u.r; const int L = u.L;
    f32x4 st[9];
    const LAS unsigned char* kp = lds + (16 * w + ql) * KV_PITCH + g * 16;
#pragma unroll
    for (int t = 0; t < 9; ++t) {
        const bf16x8 k0 = *(const LAS bf16x8*)(kp + t * 16 * KV_PITCH), k1 = *(const LAS bf16x8*)(kp + t * 16 * KV_PITCH + 64);
        f32x4 z = {0.f, 0.f, 0.f, 0.f};
        z = MFMA16(k0, qf0, z); st[t] = MFMA16(k1, qf1, z);
    }
    float mx = -1e30f;
#pragma unroll
    for (int t = 0; t < 9; ++t)
#pragma unroll
        for (int i = 0; i < 4; ++i) {
            const int diff = 16 * t + 4 * g + i - 64 - ql, jk = jq + diff;
            const bool valid = (diff >= -64) && (diff <= 64) && (jk >= 0) && (jk < L);
            const float s = valid ? st[t][i] : -1e30f; st[t][i] = s; mx = fmaxf(mx, s);
        }
    mx = fmaxf(mx, __shfl_xor(mx, 16)); mx = fmaxf(mx, __shfl_xor(mx, 32));
    float lsum = 0.f;
#pragma unroll
    for (int t = 0; t < 9; ++t)
#pragma unroll
        for (int i = 0; i < 4; ++i) { const float p = __builtin_amdgcn_exp2f(st[t][i] - mx); st[t][i] = p; lsum += p; }
    lsum += __shfl_xor(lsum, 16); lsum += __shfl_xor(lsum, 32);
    bf16x8 pf[5];
#pragma unroll
    for (int s = 0; s < 5; ++s) {
        u32x4 wv; wv.x = pk2(st[2 * s][0], st[2 * s][1]); wv.y = pk2(st[2 * s][2], st[2 * s][3]);
        if (2 * s + 1 < 9) { wv.z = pk2(st[(2 * s + 1) % 9][0], st[(2 * s + 1) % 9][1]); wv.w = pk2(st[(2 * s + 1) % 9][2], st[(2 * s + 1) % 9][3]); } else { wv.z = 0u; wv.w = 0u; }
        pf[s] = __builtin_bit_cast(bf16x8, wv);
    }
    f32x4 o[4];
#pragma unroll
    for (int dt = 0; dt < 4; ++dt) o[dt] = (f32x4){0.f, 0.f, 0.f, 0.f};
    const LAS unsigned char* vp = lds + KV_BYTES + (16 * w + 4 * g + (ql >> 2)) * KV_PITCH + (ql & 3) * 8;
#pragma unroll
    for (int s = 0; s < 5; ++s)
#pragma unroll
        for (int dt = 0; dt < 4; ++dt) {
            const s16x4 lo = vtr(vp + (32 * s) * KV_PITCH + dt * 32), hi = vtr(vp + (32 * s + 16) * KV_PITCH + dt * 32);
            const bf16x8 vf = {lo[0], lo[1], lo[2], lo[3], hi[0], hi[1], hi[2], hi[3]};
            o[dt] = MFMA16(vf, pf[s], o[dt]);
        }
    const float inv = __builtin_amdgcn_rcpf(lsum);
    bf16_t* op = OP + (size_t)u.pat * M * 512 + qrow * 512 + u.h * 64 + 4 * g;
#pragma unroll
    for (int dt = 0; dt < 4; ++dt) { u32x2 wv; wv.x = pk2(o[dt][0] * inv, o[dt][1] * inv); wv.y = pk2(o[dt][2] * inv, o[dt][3] * inv); *(u32x2*)(op + 16 * dt) = wv; }
    if (g == 0) LSE[(size_t)u.pat * M * 8 + qrow * 8 + u.h] = mx + __builtin_amdgcn_logf(lsum);
}
__device__ __forceinline__ void dattn_phase(LAS unsigned char* lds, const bf16_t* __restrict__ Qb, const bf16_t* __restrict__ Kb, const bf16_t* __restrict__ Vb, bf16_t* OP, float* LSE, int c0, int G, int tid) {
    const int lane = tid & 63, w = __builtin_amdgcn_readfirstlane(tid >> 6), ql = lane & 15, g = lane >> 4;
    int un = c0; if (un >= N_DATTN_UNITS) return;
    u32x4 kv[9]; bf16x8 qn0, qn1;
    DUnit cur = dattn_decode(un);
    dattn_issue(cur, Qb, Kb, Vb, kv, qn0, qn1, tid, w, ql, g);
#pragma unroll 1
    for (;;) {
#pragma unroll
        for (int i = 0; i < 9; ++i) {
            const int c = tid + 512 * i; const int which = c >= KV_CHUNKS; const int cc = which ? c - KV_CHUNKS : c; const int row = cc >> 3, ch = cc & 7;
            if (c < 2 * KV_CHUNKS) *(LAS u32x4*)(lds + which * KV_BYTES + row * KV_PITCH + ch * 16) = kv[i];
        }
        const bf16x8 q0 = qn0, q1 = qn1;
        __syncthreads();
        un += G; const bool has = un < N_DATTN_UNITS;
        DUnit nxt = cur;
        if (has) { nxt = dattn_decode(un); dattn_issue(nxt, Qb, Kb, Vb, kv, qn0, qn1, tid, w, ql, g); }
        dattn_compute(lds, cur, q0, q1, OP, LSE, w, ql, g);
        __syncthreads();
        if (!has) break;
        cur = nxt;
    }
}

constexpr int N_CONV_UNITS = M / 32;
__device__ __forceinline__ void conv_unit(LAS unsigned char* lds, const bf16_t* __restrict__ UC, const float* __restrict__ cw, const float* __restrict__ cb, const float* __restrict__ lg, const float* __restrict__ lb, bf16_t* MIX, int unit, int tid) {
    const int p0 = unit * 32, b = p0 >> 13, t0 = p0 & (SEQ - 1);
    LAS unsigned char* ut = lds; LAS float* ot = (LAS float*)(lds + 63488);
    {
        u32x4 tmp[8];
#pragma unroll
        for (int i = 0; i < 8; ++i) { const int c = tid + 512 * i; const int row = c >> 6, ch = c & 63, t = t0 - 15 + row;
            u32x4 v = {0u, 0u, 0u, 0u};
            if (c < 62 * 64 && t >= 0 && t < SEQ) v = *(const u32x4*)(UC + ((size_t)b * SEQ + t) * 512 + ch * 8);
            tmp[i] = v; }
#pragma unroll
        for (int i = 0; i < 8; ++i) { const int c = tid + 512 * i; const int row = c >> 6, ch = c & 63; if (c < 62 * 64) *(LAS u32x4*)(ut + row * 1024 + ch * 16) = tmp[i]; }
    }
    const int cp = tid & 255, half = tid >> 8;
    f32x2 wk[31];
#pragma unroll
    for (int k = 0; k < 31; ++k) wk[k] = *(const f32x2*)(cw + k * 512 + 2 * cp);
    const f32x2 bias = *(const f32x2*)(cb + 2 * cp);
    __syncthreads();
#pragma unroll 1
    for (int grp = 0; grp < 2; ++grp) {
        const int base = half * 16 + grp * 8;
        f32x2 acc[8];
#pragma unroll
        for (int o = 0; o < 8; ++o) acc[o] = bias;
#pragma unroll
        for (int i = 0; i < 38; ++i) {
            const unsigned xw = *(const LAS unsigned*)(ut + (base + i) * 1024 + cp * 4);
            const f32x2 x = {bflo(xw), bfhi(xw)};
#pragma unroll
            for (int o = 0; o < 8; ++o) { const int k = i - o; if (k >= 0 && k <= 30) acc[o] += wk[k < 0 ? 0 : (k > 30 ? 30 : k)] * x; }
        }
#pragma unroll
        for (int o = 0; o < 8; ++o) *(LAS f32x2*)(ot + (base + o) * 512 + 2 * cp) = acc[o];
    }
    __syncthreads();
    const int lane = tid & 63, w = tid >> 6;
    const f32x4 g0 = *(const f32x4*)(lg + 8 * lane), g1 = *(const f32x4*)(lg + 8 * lane + 4), b0 = *(const f32x4*)(lb + 8 * lane), b1 = *(const f32x4*)(lb + 8 * lane + 4);
#pragma unroll
    for (int pp = 0; pp < 4; ++pp) {
        const int pos = 4 * w + pp;
        const f32x4 x0 = *(const LAS f32x4*)(ot + pos * 512 + 8 * lane), x1 = *(const LAS f32x4*)(ot + pos * 512 + 8 * lane + 4);
        float s = (x0[0] + x0[1]) + (x0[2] + x0[3]) + (x1[0] + x1[1]) + (x1[2] + x1[3]);
        float s2 = (x0[0] * x0[0] + x0[1] * x0[1]) + (x0[2] * x0[2] + x0[3] * x0[3]) + (x1[0] * x1[0] + x1[1] * x1[1]) + (x1[2] * x1[2] + x1[3] * x1[3]);
        s = wave_sum(s); s2 = wave_sum(s2);
        const float mean = s * (1.f / 512.f), var = fmaxf(s2 * (1.f / 512.f) - mean * mean, 0.f), rstd = rsqrtf(var + EPS);
        float y[8];
#pragma unroll
        for (int j = 0; j < 4; ++j) { y[j] = (x0[j] - mean) * rstd * g0[j] + b0[j]; y[4 + j] = (x1[j] - mean) * rstd * g1[j] + b1[j]; }
#pragma unroll
        for (int j = 0; j < 8; ++j) y[j] = y[j] * __builtin_amdgcn_rcpf(1.f + __expf(-y[j]));
        u32x4 wv; wv.x = pk2(y[0], y[1]); wv.y = pk2(y[2], y[3]); wv.z = pk2(y[4], y[5]); wv.w = pk2(y[6], y[7]);
        *(u32x4*)(MIX + (size_t)(p0 + pos) * 1024 + 512 + 8 * lane) = wv;
    }
    __syncthreads();
}

__device__ __forceinline__ void merge_phase(const bf16_t* __restrict__ OP, const float* __restrict__ LSE, bf16_t* MIX, int tid) {
    for (int idx = blockIdx.x * 512 + tid; idx < M * 64; idx += gridDim.x * 512) {
        const int row = idx >> 6, hc = idx & 63, h = hc >> 3;
        const float l0 = LSE[(size_t)row * 8 + h], l1 = LSE[(size_t)M * 8 + (size_t)row * 8 + h], l2 = LSE[(size_t)2 * M * 8 + (size_t)row * 8 + h];
        const float mx = fmaxf(l0, fmaxf(l1, l2));
        float w0 = exp2f(l0 - mx), w1 = exp2f(l1 - mx), w2 = exp2f(l2 - mx);
        const float inv = 1.f / (w0 + w1 + w2); w0 *= inv; w1 *= inv; w2 *= inv;
        const u32x4 a0 = *(const u32x4*)(OP + (size_t)row * 512 + hc * 8), a1 = *(const u32x4*)(OP + (size_t)M * 512 + (size_t)row * 512 + hc * 8), a2 = *(const u32x4*)(OP + (size_t)2 * M * 512 + (size_t)row * 512 + hc * 8);
        u32x4 wv;
#pragma unroll
        for (int q = 0; q < 4; ++q) {
            const float lo = w0 * bflo(a0[q]) + w1 * bflo(a1[q]) + w2 * bflo(a2[q]);
            const float hi = w0 * bfhi(a0[q]) + w1 * bfhi(a1[q]) + w2 * bfhi(a2[q]);
            wv[q] = pk2(lo, hi);
        }
        *(u32x4*)(MIX + (size_t)row * 1024 + hc * 8) = wv;
    }
}

constexpr int XP = 528;
constexpr int N_XATTN_UNITS = BATCH * 4 * (SEQ / 256);
__device__ __forceinline__ void xattn_unit(LAS unsigned char* lds, const bf16_t* __restrict__ XQ, const bf16_t* __restrict__ XK, const bf16_t* __restrict__ XV, bf16_t* XO, int unit, int tid) {
    const int lane = tid & 63, w = __builtin_amdgcn_readfirstlane(tid >> 6), ql = lane & 15, g = lane >> 4;
    const int b = unit >> 7, xh = (unit >> 5) & 3, qb = unit & 31;
#pragma unroll 1
    for (int hb = 0; hb < 2; ++hb) {
        u32x4 tmp[8];
#pragma unroll
        for (int i = 0; i < 8; ++i) { const int c = tid + 512 * (8 * hb + i); const int row = c >> 5, ch = c & 31; tmp[i] = *(const u32x4*)(XK + (size_t)(b * NMEM + row) * 1024 + xh * 256 + ch * 8); }
#pragma unroll
        for (int i = 0; i < 8; ++i) { const int c = tid + 512 * (8 * hb + i); const int row = c >> 5, ch = c & 31; *(LAS u32x4*)(lds + row * XP + ch * 16) = tmp[i]; }
    }
    const size_t qrow0 = (size_t)b * SEQ + qb * 256 + 32 * w + ql;
    bf16x8 qf[2][8];
#pragma unroll
    for (int qt = 0; qt < 2; ++qt)
#pragma unroll
        for (int ks = 0; ks < 8; ++ks) qf[qt][ks] = *(const bf16x8*)(XQ + (qrow0 + 16 * qt) * 1024 + xh * 256 + 32 * ks + 8 * g);
    __syncthreads();
    f32x4 st[16][2];
    const LAS unsigned char* kp = lds + ql * XP + g * 16;
#pragma unroll
    for (int t = 0; t < 16; ++t) {
        f32x4 z0 = {0.f, 0.f, 0.f, 0.f}, z1 = {0.f, 0.f, 0.f, 0.f};
#pragma unroll
        for (int ks = 0; ks < 8; ++ks) { const bf16x8 kf = *(const LAS bf16x8*)(kp + t * 16 * XP + ks * 64); z0 = MFMA16(kf, qf[0][ks], z0); z1 = MFMA16(kf, qf[1][ks], z1); }
        st[t][0] = z0; st[t][1] = z1;
    }
    float inv[2];
    bf16x8 pf[2][8];
#pragma unroll
    for (int qt = 0; qt < 2; ++qt) {
        float mx = -1e30f;
#pragma unroll
        for (int t = 0; t < 16; ++t)
#pragma unroll
            for (int i = 0; i < 4; ++i) mx = fmaxf(mx, st[t][qt][i]);
        mx = fmaxf(mx, __shfl_xor(mx, 16)); mx = fmaxf(mx, __shfl_xor(mx, 32));
        float lsum = 0.f;
#pragma unroll
        for (int t = 0; t < 16; ++t)
#pragma unroll
            for (int i = 0; i < 4; ++i) { const float p = __builtin_amdgcn_exp2f(st[t][qt][i] - mx); st[t][qt][i] = p; lsum += p; }
        lsum += __shfl_xor(lsum, 16); lsum += __shfl_xor(lsum, 32);
        inv[qt] = __builtin_amdgcn_rcpf(lsum);
#pragma unroll
        for (int s = 0; s < 8; ++s) {
            u32x4 wv; wv.x = pk2(st[2 * s][qt][0], st[2 * s][qt][1]); wv.y = pk2(st[2 * s][qt][2], st[2 * s][qt][3]);
            wv.z = pk2(st[2 * s + 1][qt][0], st[2 * s + 1][qt][1]); wv.w = pk2(st[2 * s + 1][qt][2], st[2 * s + 1][qt][3]);
            pf[qt][s] = __builtin_bit_cast(bf16x8, wv);
        }
    }
    __syncthreads();
#pragma unroll 1
    for (int hb = 0; hb < 2; ++hb) {
        u32x4 tmp[8];
#pragma unroll
        for (int i = 0; i < 8; ++i) { const int c = tid + 512 * (8 * hb + i); const int row = c >> 5, ch = c & 31; tmp[i] = *(const u32x4*)(XV + (size_t)(b * NMEM + row) * 1024 + xh * 256 + ch * 8); }
#pragma unroll
        for (int i = 0; i < 8; ++i) { const int c = tid + 512 * (8 * hb + i); const int row = c >> 5, ch = c & 31; *(LAS u32x4*)(lds + row * XP + ch * 16) = tmp[i]; }
    }
    __syncthreads();
    const LAS unsigned char* vp = lds + (4 * g + (ql >> 2)) * XP + (ql & 3) * 8;
#pragma unroll
    for (int hf = 0; hf < 2; ++hf) {
        f32x4 o[8][2];
#pragma unroll
        for (int dd = 0; dd < 8; ++dd) { o[dd][0] = (f32x4){0.f, 0.f, 0.f, 0.f}; o[dd][1] = (f32x4){0.f, 0.f, 0.f, 0.f}; }
#pragma unroll
        for (int s = 0; s < 8; ++s)
#pragma unroll
            for (int dd = 0; dd < 8; ++dd) {
                const int dt = hf * 8 + dd;
                const s16x4 lo = vtr(vp + (32 * s) * XP + dt * 32), hi = vtr(vp + (32 * s + 16) * XP + dt * 32);
                const bf16x8 vf = {lo[0], lo[1], lo[2], lo[3], hi[0], hi[1], hi[2], hi[3]};
                o[dd][0] = MFMA16(vf, pf[0][s], o[dd][0]); o[dd][1] = MFMA16(vf, pf[1][s], o[dd][1]);
            }
#pragma unroll
        for (int qt = 0; qt < 2; ++qt)
#pragma unroll
            for (int dd = 0; dd < 8; ++dd) {
                u32x2 wv; wv.x = pk2(o[dd][qt][0] * inv[qt], o[dd][qt][1] * inv[qt]); wv.y = pk2(o[dd][qt][2] * inv[qt], o[dd][qt][3] * inv[qt]);
                *(u32x2*)(XO + (qrow0 + 16 * qt) * 1024 + xh * 256 + 16 * (hf * 8 + dd) + 4 * g) = wv;
            }
    }
    __syncthreads();
}

__device__ __forceinline__ void final_phase(float* out, const float* __restrict__ ss, const float* __restrict__ gfin, int tid) {
    const int lane = tid & 63, wave = tid >> 6;
    for (int row = blockIdx.x * 8 + wave; row < M; row += gridDim.x * 8) {
        float s = ss[(size_t)row * 16 + (lane & 15)];
        s += __shfl_xor(s, 1); s += __shfl_xor(s, 2); s += __shfl_xor(s, 4); s += __shfl_xor(s, 8);
        const float rstd = rsqrtf(s * (1.f / D) + EPS);
#pragma unroll
        for (int j = 0; j < 4; ++j) { float* p = out + (size_t)row * D + 4 * lane + 256 * j; const f32x4 v = *(const f32x4*)p, gg = *(const f32x4*)(gfin + 4 * lane + 256 * j); *(f32x4*)p = v * rstd * gg; }
    }
}

#define XB_TMO      128
#define XB_XCNT(j)  (256  + 64 * (j))
#define XB_XSUB(j)  (1280 + 64 * (j))
#define XB_XGEN(j)  (2304 + 64 * (j))
#define XB_TOP      3328
#define XB_TOPGEN   3392
#define XCD_BAR_WORDS 3456
#define XB_SPIN_CAP (1u << 18)

__device__ __forceinline__ unsigned xb_ld(unsigned* p)              { return __hip_atomic_load(p, __ATOMIC_RELAXED, __HIP_MEMORY_SCOPE_AGENT); }
__device__ __forceinline__ unsigned xb_add(unsigned* p, unsigned v) { return __hip_atomic_fetch_add(p, v, __ATOMIC_RELAXED, __HIP_MEMORY_SCOPE_AGENT); }
__device__ __forceinline__ unsigned xb_xcc_id() { return (unsigned)__builtin_amdgcn_s_getreg((3 << 11) | 20) & 0xFu; }
#define XB_SPIN(cond, bar) do { unsigned _sp = 0; while (cond) { __builtin_amdgcn_s_sleep(1); \
    if ((++_sp & 255u) == 0u) { if (xb_ld(&(bar)[XB_TMO])) break; if (_sp > XB_SPIN_CAP) { atomicAdd(&(bar)[XB_TMO], 1u); break; } } } } while (0)

struct XcdBarrier {
    unsigned* bar; unsigned x;
    volatile LAS unsigned* st;
};

__device__ __forceinline__ XcdBarrier xcd_barrier_post(unsigned* bar, volatile LAS unsigned* st) {
    XcdBarrier b; b.bar = bar; b.x = xb_xcc_id(); b.st = st;
    if (threadIdx.x == 0) (void)xb_add(&bar[XB_XCNT(b.x)], 1u);
    return b;
}
__device__ __forceinline__ void xcd_barrier_complete(unsigned* bar, unsigned x, unsigned& nloc, unsigned& nx) {
    const unsigned G = gridDim.x * gridDim.y * gridDim.z;
    unsigned sum, cnt, mine, sp = 0u;
    for (;;) {
        sum = 0u; cnt = 0u; mine = 0u;
#pragma unroll
        for (unsigned j = 0; j < 16; ++j) { const unsigned c = xb_ld(&bar[XB_XCNT(j)]); sum += c; cnt += (c > 0u) ? 1u : 0u; mine = (j == x) ? c : mine; }
        if (sum == G) break;
        __builtin_amdgcn_s_sleep(1);
        if ((++sp & 255u) == 0u) { if (xb_ld(&bar[XB_TMO])) break; if (sp > XB_SPIN_CAP) { atomicAdd(&bar[XB_TMO], 1u); break; } }
    }
    nloc = mine > 0u ? mine : 1u; nx = cnt > 0u ? cnt : 1u;
}

__device__ __forceinline__ void xcd_barrier(const XcdBarrier& b) {
    asm volatile("s_waitcnt vmcnt(0)" ::: "memory");
    __syncthreads();
    if (threadIdx.x == 0) {
        unsigned* bar = b.bar;
        __builtin_amdgcn_s_waitcnt(0);
        unsigned nloc = b.st[0], nx = b.st[1];
        if (nloc == 0u) { xcd_barrier_complete(bar, b.x, nloc, nx); b.st[0] = nloc; b.st[1] = nx; }
        const unsigned old = xb_add(&bar[XB_XSUB(b.x)], 1u);
        const unsigned gen = old / nloc;
        if (old + 1u == (gen + 1u) * nloc) {
            __builtin_amdgcn_fence(__ATOMIC_RELEASE, "agent");
            asm volatile("s_waitcnt vmcnt(0)" ::: "memory");
            const unsigned og = xb_add(&bar[XB_TOP], 1u);
            const unsigned tg = og / nx;
            if (og + 1u == (tg + 1u) * nx) xb_add(&bar[XB_TOPGEN], 1u);
            else XB_SPIN(xb_ld(&bar[XB_TOPGEN]) == tg, bar);
            __builtin_amdgcn_fence(__ATOMIC_ACQUIRE, "agent");
            xb_add(&bar[XB_XGEN(b.x)], 1u);
            asm volatile("s_waitcnt vmcnt(0)" ::: "memory");
        } else {
            XB_SPIN(xb_ld(&bar[XB_XGEN(b.x)]) == gen, bar);
            __builtin_amdgcn_fence(__ATOMIC_ACQUIRE, "agent");
            asm volatile("s_waitcnt vmcnt(0)" ::: "memory");
        }
    }
    __syncthreads();
}


__global__ void __launch_bounds__(512, 2) fwd_megakernel(Args a) {
    extern __shared__ __attribute__((aligned(16))) unsigned char lds_raw[];
    LAS unsigned char* lds = (LAS unsigned char*)lds_raw;
    const int tid = threadIdx.x;
    unsigned char* ws = a.ws;
    const int lo = a.ph_lo, hi = a.ph_hi;
    const int G = gridDim.x, c = blockIdx.x;
    bf16_t* XN = (bf16_t*)(ws + WS_XN);
    volatile LAS unsigned* bst = (volatile LAS unsigned*)(lds + LDS_BYTES - 64);
    if (tid == 0) { bst[0] = 0u; bst[1] = 0u; }
    __syncthreads();
    XcdBarrier bar = xcd_barrier_post((unsigned*)ws, bst);
    if (a.ph_hi < 0) cg::this_grid().sync();
#define IN(k) (lo <= (k) && (k) < hi)
#define SEAM(k) do { if (IN(k) && IN((k) + 1)) xcd_barrier(bar); } while (0)

#ifndef PROBE_P0
#define PROBE_P0 0
#define PROBE_P2 0
#define PROBE_P6 0
#define PROBE_SYNC 0
#define PROBE_P3 0
#endif
    if (IN(0)) p0_prologue(lds, a, tid);
#if PROBE_P0
    if (IN(0)) p0_prologue(lds, a, tid);
#endif
    #if PROBE_SYNC
    _Pragma("unroll 1") for (int rep = 0; rep < PROBE_SYNC; ++rep) xcd_barrier(bar);
#endif
    SEAM(0);
    if (IN(1)) {
        { pg8::Gemm g{XN, (const bf16_t*)(ws + WS_WIN), M, DIN, D}; pg8::StaticOrder S; S.init(M, DIN, G, c);
          EpiIn E{(bf16_t*)(ws + WS_QB), (bf16_t*)(ws + WS_KB), (bf16_t*)(ws + WS_VB), (bf16_t*)(ws + WS_UC), (const float*)(ws + WS_CS)};
          pg8::gemm_phase<EpiIn, pg8::StaticOrder, true, true>(lds, g, S, E); }
        { const int c2 = (c + G - (640 % G)) % G;
          pg8::Gemm g{(const bf16_t*)(ws + WS_MN), (const bf16_t*)(ws + WS_WXKV), MM, 2048, D}; pg8::StaticOrder S; S.init(MM, 2048, G, c2);
          EpiKV E{(bf16_t*)(ws + WS_XK), (bf16_t*)(ws + WS_XV)};
          pg8::gemm_phase<EpiKV, pg8::StaticOrder, true, true>(lds, g, S, E); }
    }
    SEAM(1);
    if (IN(2)) {
        dattn_phase(lds, (const bf16_t*)(ws + WS_QB), (const bf16_t*)(ws + WS_KB), (const bf16_t*)(ws + WS_VB), (bf16_t*)(ws + WS_OP), (float*)(ws + WS_LSE), c, G, tid);
        for (int u = c; u < N_CONV_UNITS; u += G) conv_unit(lds, (const bf16_t*)(ws + WS_UC), a.in[4], a.in[5], a.in[6], a.in[7], (bf16_t*)(ws + WS_MIX), u, tid);
    }
    #if PROBE_P2
    __syncthreads();
if (IN(2)) {
        dattn_phase(lds, (const bf16_t*)(ws + WS_QB), (const bf16_t*)(ws + WS_KB), (const bf16_t*)(ws + WS_VB), (bf16_t*)(ws + WS_OP), (float*)(ws + WS_LSE), c, G, tid);
        for (int u = c; u < N_CONV_UNITS; u += G) conv_unit(lds, (const bf16_t*)(ws + WS_UC), a.in[4], a.in[5], a.in[6], a.in[7], (bf16_t*)(ws + WS_MIX), u, tid);
    }
    #endif
    SEAM(2);
    if (IN(3)) merge_phase((const bf16_t*)(ws + WS_OP), (const float*)(ws + WS_LSE), (bf16_t*)(ws + WS_MIX), tid);
    #if PROBE_P3
if (IN(3)) merge_phase((const bf16_t*)(ws + WS_OP), (const float*)(ws + WS_LSE), (bf16_t*)(ws + WS_MIX), tid);
    #endif
    SEAM(3);
    if (IN(4)) { pg8::Gemm g{(const bf16_t*)(ws + WS_MIX), (const bf16_t*)(ws + WS_WOUT), M, D, D}; pg8::StaticOrder S; S.init(M, D, G, c);
        EpiRes<false, false, true> E{a.in[0], nullptr, nullptr, XN, (float*)(ws + WS_SS1)};
        pg8::gemm_phase<EpiRes<false, false, true>, pg8::StaticOrder, true, true>(lds, g, S, E); }
    SEAM(4);
    if (IN(5)) { pg8::Gemm g{XN, (const bf16_t*)(ws + WS_WXQ), M, D, D}; pg8::StaticOrder S; S.init(M, D, G, c);
        EpiScale<0> E{(bf16_t*)(ws + WS_XQ), D, (const float*)(ws + WS_SS1), XQSCALE};
        pg8::gemm_phase<EpiScale<0>, pg8::StaticOrder, true, true>(lds, g, S, E); }
    SEAM(5);
    if (IN(6)) { for (int u = c; u < N_XATTN_UNITS; u += G) xattn_unit(lds, (const bf16_t*)(ws + WS_XQ), (const bf16_t*)(ws + WS_XK), (const bf16_t*)(ws + WS_XV), (bf16_t*)(ws + WS_XO), u, tid); }
    #if PROBE_P6
if (IN(6)) { for (int u = c; u < N_XATTN_UNITS; u += G) xattn_unit(lds, (const bf16_t*)(ws + WS_XQ), (const bf16_t*)(ws + WS_XK), (const bf16_t*)(ws + WS_XV), (bf16_t*)(ws + WS_XO), u, tid); }
    #endif
    SEAM(6);
    if (IN(7)) { pg8::Gemm g{(const bf16_t*)(ws + WS_XO), (const bf16_t*)(ws + WS_WXO), M, D, D}; pg8::StaticOrder S; S.init(M, D, G, c);
        EpiRes<true, false, true> E{nullptr, XN, nullptr, XN, (float*)(ws + WS_SS2)};
        pg8::gemm_phase<EpiRes<true, false, true>, pg8::StaticOrder, true, true>(lds, g, S, E); }
    SEAM(7);
    if (IN(8)) { pg8::Gemm g{XN, (const bf16_t*)(ws + WS_WUP), M, FF, D}; pg8::StaticOrder S; S.init(M, FF, G, c);
        EpiScale<1> E{(bf16_t*)(ws + WS_U), FF, (const float*)(ws + WS_SS2), 1.f};
        pg8::gemm_phase<EpiScale<1>, pg8::StaticOrder, true, true>(lds, g, S, E); }
    SEAM(8);
    if (IN(9)) { pg8::Gemm g{(const bf16_t*)(ws + WS_U), (const bf16_t*)(ws + WS_WDN), M, D, FF}; pg8::StaticOrder S; S.init(M, D, G, c);
        EpiRes<true, true, false> E{nullptr, XN, a.out, nullptr, (float*)(ws + WS_SS3)};
        pg8::gemm_phase<EpiRes<true, true, false>, pg8::StaticOrder, true, true>(lds, g, S, E); }
    SEAM(9);
    if (IN(10)) final_phase(a.out, (const float*)(ws + WS_SS3), a.in[18], tid);
#undef IN
#undef SEAM
}

#ifndef MK_SPLIT
#define MK_SPLIT 0
#endif
extern "C" void kernel_launch(void* const* d_in, const int* in_sizes, int n_in, void* d_out, int out_size, void* d_ws, size_t ws_size, hipStream_t stream) {
    static int grid = 0;
    if (grid == 0) {
        int dev = 0, cus = 0, per_cu = 0;
        hipGetDevice(&dev);
        hipDeviceGetAttribute(&cus, hipDeviceAttributeMultiprocessorCount, dev);
        if (hipFuncSetAttribute((const void*)fwd_megakernel, hipFuncAttributeMaxDynamicSharedMemorySize, LDS_BYTES) != hipSuccess) fprintf(stderr, "kernel_launch: hipFuncSetAttribute failed\n");
        if (hipOccupancyMaxActiveBlocksPerMultiprocessor(&per_cu, (const void*)fwd_megakernel, 512, LDS_BYTES) != hipSuccess || per_cu < 1) { fprintf(stderr, "kernel_launch: occupancy query says %d\n", per_cu); per_cu = 1; }
        (void)hipGetLastError();
        grid = cus > 0 ? cus : 256;
        if (n_in != 19 || ws_size < WS_END) fprintf(stderr, "kernel_launch: unexpected n_in %d / ws_size %zu\n", n_in, ws_size);
    }
    Args a{};
    for (int i = 0; i < 19; ++i) a.in[i] = (const float*)d_in[i];
    a.out = (float*)d_out; a.ws = (unsigned char*)d_ws;
#if MK_SPLIT
    for (int p = 0; p < NPH; ++p) { a.ph_lo = p; a.ph_hi = p + 1; hipLaunchKernelGGL(fwd_megakernel, dim3(grid), dim3(512), LDS_BYTES, stream, a); }
#else
    a.ph_lo = 0; a.ph_hi = NPH;
    if (hipMemsetAsync(d_ws, 0, 16384, stream) != hipSuccess) fprintf(stderr, "kernel_launch: memset of the barrier words failed\n");
    void* args[] = {&a};
    hipError_t e = hipLaunchCooperativeKernel((const void*)fwd_megakernel, dim3(grid), dim3(512), args, LDS_BYTES, stream);
    if (e != hipSuccess) fprintf(stderr, "kernel_launch: cooperative launch failed: %s (grid %d)\n", hipGetErrorString(e), grid);
#endif
}
```

```cpp
#include <hip/hip_runtime.h>
#include <hip/hip_cooperative_groups.h>
#include <cstdio>
#include <cstdint>
namespace cg = cooperative_groups;
namespace pg8 {
#define PG8_LAS __attribute__((address_space(3)))
typedef unsigned short bf16_t;
typedef short bf16x8 __attribute__((ext_vector_type(8)));
typedef float f32x4 __attribute__((ext_vector_type(4)));
typedef unsigned u32x4 __attribute__((ext_vector_type(4)));
constexpr int BM = 256, BK = 64, HALF = 128, HTB = HALF * BK * 2  , STAGE_BYTES = 8 * HTB, NXCD = 8, WGM = 8;

__host__ __device__ __forceinline__ int lds_byte(int r, int c) { const int st = (r >> 4) * 2 + (c >> 5), rr = r & 15, cc = c & 31, ob = rr * 64 + cc * 2; return st * 1024 + (ob ^ (((ob >> 9) & 1) << 5)); }
__host__ __device__ __forceinline__ void stage_rc(int b, int& R, int& C) { const int st = b / 1024, sb = b % 1024, swz = sb ^ (((sb >> 9) & 1) << 5); R = (st >> 1) * 16 + swz / 64; C = (st & 1) * 32 + (swz % 64) / 2; }
__host__ __device__ __forceinline__ int perm32(int rho) { const int n = rho >> 4, i = rho & 15; return 8 * (i >> 2) + 4 * n + (i & 3); }

struct Unit { int pm, pn; };
struct Gemm { const bf16_t* A; const bf16_t* Bt; int M, N, K; };

struct StaticOrder {
    int nM, nN, nwg, G, c;
    __host__ __device__ void init(int M, int N, int G_, int c_) { nM = M / BM; nN = N / BM; nwg = nM * nN; G = G_; c = c_; }
    __host__ __device__ bool next(int i, Unit& u) const {
        const long L = (long)i * G + c; if (L >= nwg) return false;
        int wgid = (int)L; { const int q = nwg / NXCD, r = nwg % NXCD, xcd = wgid % NXCD, off = wgid / NXCD; wgid = (xcd < r ? xcd * (q + 1) : r * (q + 1) + (xcd - r) * q) + off; }
        const int nig = WGM * nN, gid = wgid / nig, fm = gid * WGM, gsz = (nM - fm) < WGM ? (nM - fm) : WGM;
        u.pm = fm + ((wgid % nig) % gsz); u.pn = (wgid % nig) / gsz; return true;
    }
    __device__ __forceinline__ void a_ready(const Unit&) const {}
    __device__ __forceinline__ void done(const Unit&) const {}
};
__device__ __forceinline__ unsigned cvt_pk_bf16(float lo, float hi) { unsigned r; asm volatile("v_cvt_pk_bf16_f32 %0, %1, %2" : "=v"(r) : "v"(lo), "v"(hi)); return r; }
template <class Epi, class Sched, bool ALIGN_EPI = false, bool SP2 = false>
__device__ __forceinline__ void gemm_phase(PG8_LAS unsigned char* lds, const Gemm g, const Sched& S, const Epi& E) {
    const int tid = threadIdx.x, wid = __builtin_amdgcn_readfirstlane(tid >> 6), lane = tid & 63, wr = wid >> 2, wc = wid & 3, fr = lane & 15, fq = lane >> 4;
    const int K = g.K, nt = K / BK;
    unsigned voffA[2], voffB[2];
#pragma unroll
    for (int i = 0; i < 2; ++i) { int R, C; stage_rc(tid * 16 + i * 8192, R, C); const int Rb = Epi::PERM ? ((R & ~31) + perm32(R & 31)) : R;
        voffA[i] = (unsigned)(R * K + C) * 2u; voffB[i] = (unsigned)(Rb * K + C) * 2u; }
    const size_t kstep = (size_t)(BK * 2);
    const size_t hstep = (size_t)HALF * K * 2;
    const size_t tstep = 2 * hstep;
    const unsigned ldsw = (unsigned)wid * 1024u;
    const int aoff = lds_byte(wr * 64 + fr, fq * 8), boff = lds_byte(wc * 32 + fr, fq * 8);
#define PG8_SA(b, h) (((b) * 2 + (h)) * HTB)
#define PG8_SB(b, h) ((4 + (b) * 2 + (h)) * HTB)
#define PG8_STAGE(bufoff, gbase, voff) do { _Pragma("unroll") for (int _i = 0; _i < 2; ++_i) \
        __builtin_amdgcn_global_load_lds((const unsigned*)((const char*)(gbase) + (voff)[_i]), (PG8_LAS unsigned*)(lds + (bufoff) + ldsw + _i * 8192), 16, 0, 0); } while (0)
#define PG8_LDA(dst, b, h) do { _Pragma("unroll") for (int m = 0; m < 4; ++m) _Pragma("unroll") for (int k = 0; k < 2; ++k) dst[m][k] = *(const PG8_LAS bf16x8*)(lds + PG8_SA(b, h) + aoff + m * 2048 + k * 1024); } while (0)
#define PG8_LDB(dst, b, h) do { _Pragma("unroll") for (int n = 0; n < 2; ++n) _Pragma("unroll") for (int k = 0; k < 2; ++k) dst[n][k] = *(const PG8_LAS bf16x8*)(lds + PG8_SB(b, h) + boff + n * 2048 + k * 1024); } while (0)
#define PG8_MMA(ai, bj, At, Bt) do { __builtin_amdgcn_s_setprio(1); _Pragma("unroll") for (int m = 0; m < 4; ++m) _Pragma("unroll") for (int n = 0; n < 2; ++n) _Pragma("unroll") for (int k = 0; k < 2; ++k) \
        acc[ai][bj][m][n] = __builtin_amdgcn_mfma_f32_16x16x32_bf16(Bt[n][k], At[m][k], acc[ai][bj][m][n], 0, 0, 0); __builtin_amdgcn_s_setprio(0); } while (0)
#define PG8_WAIT_V(n) asm volatile("s_waitcnt vmcnt(" #n ")" ::: "memory")
#define PG8_WAIT_L(n) asm volatile("s_waitcnt lgkmcnt(" #n ")" ::: "memory")
#define PG8_BAR __builtin_amdgcn_s_barrier()
#define PG8_SCHED __builtin_amdgcn_sched_barrier(0)
    Unit cur, nxt; int ui = 0;
    if (!S.next(0, cur)) return;
    f32x4 acc[2][2][4][2];
#pragma unroll
    for (int a = 0; a < 2; ++a)
#pragma unroll
        for (int b = 0; b < 2; ++b)
#pragma unroll
            for (int m = 0; m < 4; ++m)
#pragma unroll
                for (int n = 0; n < 2; ++n) acc[a][b][m][n] = (f32x4){0.f, 0.f, 0.f, 0.f};
    bf16x8 At[4][2], B0[2][2], B1[2][2];
    const char* cA = (const char*)g.A + (size_t)cur.pm * tstep; const char* cB = (const char*)g.Bt + (size_t)cur.pn * tstep;
    S.a_ready(cur);
    if constexpr (SP2) {
        PG8_STAGE(PG8_SB(0, 0), cB, voffB); PG8_STAGE(PG8_SB(0, 1), cB + hstep, voffB); PG8_STAGE(PG8_SA(0, 0), cA, voffA); PG8_STAGE(PG8_SA(0, 1), cA + hstep, voffA);
        if (wr == 1) PG8_BAR;
        PG8_WAIT_V(2); PG8_BAR;
        PG8_STAGE(PG8_SB(1, 0), cB + kstep, voffB); PG8_STAGE(PG8_SA(1, 0), cA + kstep, voffA); PG8_STAGE(PG8_SB(1, 1), cB + hstep + kstep, voffB);
        PG8_WAIT_V(6); PG8_BAR;
    } else {
        PG8_STAGE(PG8_SB(0, 0), cB, voffB); PG8_STAGE(PG8_SA(0, 0), cA, voffA); PG8_STAGE(PG8_SB(0, 1), cB + hstep, voffB); PG8_STAGE(PG8_SA(0, 1), cA + hstep, voffA);
        if (wr == 1) PG8_BAR;
        PG8_WAIT_V(4); PG8_BAR;
        PG8_STAGE(PG8_SB(1, 0), cB + kstep, voffB); PG8_STAGE(PG8_SA(1, 0), cA + kstep, voffA); PG8_STAGE(PG8_SB(1, 1), cB + hstep + kstep, voffB);
        PG8_WAIT_V(6); PG8_BAR;
    }
    for (;;) {
        const bool has_next = S.next(ui + 1, nxt);
        const char* nA = has_next ? (const char*)g.A + (size_t)nxt.pm * tstep : cA; const char* nB = has_next ? (const char*)g.Bt + (size_t)nxt.pn * tstep : cB;
        for (int t = 0; t < nt; t += 2) {
            const bool last = (t == nt - 2);
            const char* a1 = cA + (size_t)(t + 1) * kstep;
            const char* a2 = last ? nA : cA + (size_t)(t + 2) * kstep; const char* b2 = last ? nB : cB + (size_t)(t + 2) * kstep;
            const char* a3 = a2 + kstep; const char* b3 = b2 + kstep;
            if (last && has_next) S.a_ready(nxt);
            if constexpr (SP2) {
            PG8_LDB(B0, 0, 0); PG8_LDB(B1, 0, 1); PG8_SCHED; PG8_LDA(At, 0, 0); PG8_STAGE(PG8_SA(1, 1), a1 + hstep, voffA);
            PG8_WAIT_V(8); PG8_WAIT_L(0); PG8_BAR; PG8_MMA(0, 0, At, B0); PG8_MMA(0, 1, At, B1); PG8_BAR; PG8_SCHED;
            PG8_LDA(At, 0, 1); PG8_STAGE(PG8_SB(0, 0), b2, voffB); PG8_STAGE(PG8_SB(0, 1), b2 + hstep, voffB); PG8_STAGE(PG8_SA(0, 0), a2, voffA);
            PG8_WAIT_V(8); PG8_WAIT_L(0); PG8_BAR; PG8_MMA(1, 0, At, B0); PG8_MMA(1, 1, At, B1); PG8_BAR; PG8_SCHED;
            PG8_LDB(B0, 1, 0); PG8_LDB(B1, 1, 1); PG8_SCHED; PG8_LDA(At, 1, 0); PG8_STAGE(PG8_SA(0, 1), a2 + hstep, voffA);
            PG8_WAIT_V(8); PG8_WAIT_L(0); PG8_BAR; PG8_MMA(0, 0, At, B0); PG8_MMA(0, 1, At, B1); PG8_BAR; PG8_SCHED;
            PG8_LDA(At, 1, 1); PG8_STAGE(PG8_SB(1, 0), b3, voffB); PG8_STAGE(PG8_SB(1, 1), b3 + hstep, voffB); PG8_STAGE(PG8_SA(1, 0), a3, voffA);
            PG8_WAIT_V(8); PG8_WAIT_L(0); PG8_BAR; PG8_MMA(1, 0, At, B0); PG8_MMA(1, 1, At, B1); PG8_BAR; PG8_SCHED;
            } else {
            PG8_LDB(B0, 0, 0); PG8_SCHED; PG8_LDA(At, 0, 0); PG8_STAGE(PG8_SA(1, 1), a1 + hstep, voffA);
            PG8_WAIT_L(8); PG8_BAR; PG8_WAIT_L(0); PG8_MMA(0, 0, At, B0); PG8_BAR; PG8_SCHED;
            PG8_LDB(B1, 0, 1); PG8_STAGE(PG8_SB(0, 0), b2, voffB);
            PG8_BAR; PG8_WAIT_L(0); PG8_MMA(0, 1, At, B1); PG8_BAR;
            PG8_LDA(At, 0, 1); PG8_STAGE(PG8_SA(0, 0), a2, voffA);
            PG8_BAR; PG8_WAIT_L(0); PG8_MMA(1, 0, At, B0); PG8_BAR; PG8_SCHED;
            PG8_STAGE(PG8_SB(0, 1), b2 + hstep, voffB);
            PG8_WAIT_V(6); PG8_BAR; PG8_MMA(1, 1, At, B1); PG8_BAR;
            PG8_LDB(B0, 1, 0); PG8_SCHED; PG8_LDA(At, 1, 0); PG8_STAGE(PG8_SA(0, 1), a2 + hstep, voffA);
            PG8_WAIT_L(8); PG8_BAR; PG8_WAIT_L(0); PG8_MMA(0, 0, At, B0); PG8_BAR; PG8_SCHED;
            PG8_LDB(B1, 1, 1); PG8_STAGE(PG8_SB(1, 0), b3, voffB);
            PG8_BAR; PG8_WAIT_L(0); PG8_MMA(0, 1, At, B1); PG8_BAR;
            PG8_LDA(At, 1, 1); PG8_STAGE(PG8_SA(1, 0), a3, voffA);
            PG8_BAR; PG8_WAIT_L(0); PG8_MMA(1, 0, At, B0); PG8_BAR; PG8_SCHED;
            PG8_STAGE(PG8_SB(1, 1), b3 + hstep, voffB);
            PG8_WAIT_V(6); PG8_BAR; PG8_MMA(1, 1, At, B1); PG8_BAR;
            }
        }
        if constexpr (ALIGN_EPI) { if (wr == 0) PG8_BAR; }
        if constexpr (!Epi::AFTER_DRAIN) { E(acc, cur, wr, wc, fr, fq); S.done(cur); }
        if (!has_next) break;
#pragma unroll
        for (int a = 0; a < 2; ++a)
#pragma unroll
            for (int b = 0; b < 2; ++b)
#pragma unroll
                for (int m = 0; m < 4; ++m)
#pragma unroll
                    for (int n = 0; n < 2; ++n) acc[a][b][m][n] = (f32x4){0.f, 0.f, 0.f, 0.f};
        cur = nxt; cA = nA; cB = nB; ++ui;
        if constexpr (ALIGN_EPI) { if (wr == 1) PG8_BAR; }
    }
    PG8_WAIT_V(0);
    if constexpr (!ALIGN_EPI) { if (wr == 0) PG8_BAR; }
    PG8_BAR;
    if constexpr (Epi::AFTER_DRAIN) { E.fused(acc, cur, wr, wc, fr, fq, lds, wid, lane); S.done(cur); }
#undef PG8_SA
#undef PG8_SB
#undef PG8_STAGE
#undef PG8_LDA
#undef PG8_LDB
#undef PG8_MMA
#undef PG8_WAIT_V
#undef PG8_WAIT_L
#undef PG8_BAR
#undef PG8_SCHED
}
}

constexpr int SEQ = 8192, BATCH = 2, M = BATCH * SEQ, D = 1024, DIN = 2560, FF = 4096, NMEM = 256, MM = BATCH * NMEM;
constexpr float EPS = 1e-6f;
constexpr float LOG2E = 1.4426950408889634f;
constexpr float QSCALE = 0.125f * LOG2E;
constexpr float XQSCALE = 0.0625f * LOG2E;

typedef unsigned short bf16_t;
using pg8::bf16x8; using pg8::f32x4; using pg8::u32x4;
typedef short s16x4 __attribute__((ext_vector_type(4)));
typedef short v4i16_t __attribute__((ext_vector_type(4)));
typedef float f32x2 __attribute__((ext_vector_type(2)));
typedef unsigned u32x2 __attribute__((ext_vector_type(2)));
#define LAS __attribute__((address_space(3)))

constexpr size_t MiB = 1u << 20;
constexpr size_t WS_CS = 1 * MiB, WS_SS1 = 2 * MiB, WS_SS2 = 3 * MiB, WS_SS3 = 4 * MiB, WS_LSE = 5 * MiB, WS_MN = 7 * MiB, WS_XK = 8 * MiB, WS_XV = 9 * MiB;
constexpr size_t WS_WIN = 10 * MiB, WS_WOUT = 15 * MiB, WS_WXQ = 17 * MiB, WS_WXKV = 19 * MiB, WS_WXO = 23 * MiB, WS_WUP = 25 * MiB, WS_WDN = 33 * MiB;
constexpr size_t WS_XN = 42 * MiB, WS_QB = 74 * MiB, WS_KB = 90 * MiB, WS_VB = 106 * MiB, WS_UC = 122 * MiB, WS_MIX = 138 * MiB, WS_OP = 170 * MiB;
constexpr size_t WS_XQ = 74 * MiB, WS_XO = 106 * MiB, WS_U = 74 * MiB, WS_END = 218 * MiB;
constexpr int LDS_BYTES = 147456;
constexpr int NPH = 11;

struct Args { const float* in[19]; float* out; unsigned char* ws; int ph_lo, ph_hi; };

__device__ __forceinline__ unsigned pk2(float lo, float hi) { return pg8::cvt_pk_bf16(lo, hi); }
__device__ __forceinline__ float bflo(unsigned w) { return __uint_as_float(w << 16); }
__device__ __forceinline__ float bfhi(unsigned w) { return __uint_as_float(w & 0xffff0000u); }
__device__ __forceinline__ float wave_sum(float v) {
#pragma unroll
    for (int o = 1; o < 64; o <<= 1) v += __shfl_xor(v, o);
    return v;
}
#define MFMA16(a, b, c) __builtin_amdgcn_mfma_f32_16x16x32_bf16((a), (b), (c), 0, 0, 0)
__device__ __forceinline__ s16x4 vtr(const LAS unsigned char* p) { return __builtin_bit_cast(s16x4, __builtin_amdgcn_ds_read_tr16_b64_v4i16((LAS v4i16_t*)p)); }

struct EpiIn {
    static constexpr bool PERM = true, AFTER_DRAIN = false;
    bf16_t *Qb, *Kb, *Vb, *UC; const float* CS;
    __device__ __forceinline__ void operator()(const f32x4 (&acc)[2][2][4][2], const pg8::Unit& u, int wr, int wc, int fr, int fq) const {
        const int row0 = u.pm * 256 + wr * 64 + fr;
        if (u.pn >= 6) {
            const int ch0 = (u.pn - 6) * 128 + wc * 32 + 8 * fq;
#pragma unroll
            for (int ai = 0; ai < 2; ++ai)
#pragma unroll
                for (int m = 0; m < 4; ++m) {
                    const int row = row0 + ai * 128 + m * 16;
                    float r[8];
#pragma unroll
                    for (int n = 0; n < 2; ++n)
#pragma unroll
                        for (int j = 0; j < 4; ++j) { const float a = acc[ai][0][m][n][j], g = acc[ai][1][m][n][j]; r[4 * n + j] = a * __builtin_amdgcn_rcpf(1.f + __expf(-g)); }
                    u32x4 w; w.x = pk2(r[0], r[1]); w.y = pk2(r[2], r[3]); w.z = pk2(r[4], r[5]); w.w = pk2(r[6], r[7]);
                    *(u32x4*)(UC + (size_t)row * 512 + ch0) = w;
                }
        } else if (u.pn >= 4) {
            const int col0 = (u.pn - 4) * 256 + wc * 32 + 8 * fq;
#pragma unroll
            for (int ai = 0; ai < 2; ++ai)
#pragma unroll
                for (int m = 0; m < 4; ++m) {
                    const int row = row0 + ai * 128 + m * 16;
#pragma unroll
                    for (int bj = 0; bj < 2; ++bj) {
                        const f32x4 v0 = acc[ai][bj][m][0], v1 = acc[ai][bj][m][1];
                        u32x4 w; w.x = pk2(v0[0], v0[1]); w.y = pk2(v0[2], v0[3]); w.z = pk2(v1[0], v1[1]); w.w = pk2(v1[2], v1[3]);
                        *(u32x4*)(Vb + (size_t)row * 512 + col0 + bj * 128) = w;
                    }
                }
        } else {
            bf16_t* dst = (u.pn < 2) ? Qb : Kb; const float sc = (u.pn < 2) ? QSCALE : 1.f;
            const int col0 = (u.pn & 1) * 256 + wc * 32 + 8 * fq;
            const bool rope_wave = (wc & 1) == 0;
            const float sgn = (fq == 0) ? -1.f : 1.f;
#pragma unroll
            for (int ai = 0; ai < 2; ++ai)
#pragma unroll
                for (int m = 0; m < 4; ++m) {
                    const int row = row0 + ai * 128 + m * 16;
                    const int pos = row & (SEQ - 1);
                    f32x4 cs[4];
                    if (rope_wave && fq < 2) {
#pragma unroll
                        for (int q = 0; q < 4; ++q) cs[q] = *(const f32x4*)(CS + (size_t)pos * 16 + 4 * q);
                    }
#pragma unroll
                    for (int bj = 0; bj < 2; ++bj) {
                        float v[8];
#pragma unroll
                        for (int n = 0; n < 2; ++n)
#pragma unroll
                            for (int j = 0; j < 4; ++j) v[4 * n + j] = acc[ai][bj][m][n][j];
                        if (rope_wave) {
#pragma unroll
                            for (int i = 0; i < 8; ++i) {
                                const float p = __shfl_xor(v[i], 16);
                                if (fq < 2) { const float c = cs[i >> 1][2 * (i & 1)], s = cs[i >> 1][2 * (i & 1) + 1]; v[i] = v[i] * c + sgn * p * s; }
                            }
                        }
                        u32x4 w; w.x = pk2(v[0] * sc, v[1] * sc); w.y = pk2(v[2] * sc, v[3] * sc); w.z = pk2(v[4] * sc, v[5] * sc); w.w = pk2(v[6] * sc, v[7] * sc);
                        *(u32x4*)(dst + (size_t)row * 512 + col0 + bj * 128) = w;
                    }
                }
        }
    }
};
struct EpiKV {
    static constexpr bool PERM = true, AFTER_DRAIN = false;
    bf16_t *XK, *XV;
    __device__ __forceinline__ void operator()(const f32x4 (&acc)[2][2][4][2], const pg8::Unit& u, int wr, int wc, int fr, int fq) const {
        const int row0 = u.pm * 256 + wr * 64 + fr;
        bf16_t* dst = (u.pn < 4) ? XK : XV; const int col0 = (u.pn & 3) * 256 + wc * 32 + 8 * fq;
#pragma unroll
        for (int ai = 0; ai < 2; ++ai)
#pragma unroll
            for (int m = 0; m < 4; ++m) {
                const int row = row0 + ai * 128 + m * 16;
#pragma unroll
                for (int bj = 0; bj < 2; ++bj) {
                    const f32x4 v0 = acc[ai][bj][m][0], v1 = acc[ai][bj][m][1];
                    u32x4 w; w.x = pk2(v0[0], v0[1]); w.y = pk2(v0[2], v0[3]); w.z = pk2(v1[0], v1[1]); w.w = pk2(v1[2], v1[3]);
                    *(u32x4*)(dst + (size_t)row * 1024 + col0 + bj * 128) = w;
                }
            }
    }
};
template <bool BASE_BF16, bool OUT_F32, bool OUT_BF16> struct EpiRes {
    static constexpr bool PERM = true, AFTER_DRAIN = false;
    const float* base; const bf16_t* baseb; float* out; bf16_t* xn; float* ss;
    __device__ __forceinline__ void operator()(const f32x4 (&acc)[2][2][4][2], const pg8::Unit& u, int wr, int wc, int fr, int fq) const {
        const int row0 = u.pm * 256 + wr * 64 + fr; const int col0 = u.pn * 256 + wc * 32 + 8 * fq;
#pragma unroll
        for (int ai = 0; ai < 2; ++ai)
#pragma unroll
            for (int m = 0; m < 4; ++m) {
                const int row = row0 + ai * 128 + m * 16;
                float s = 0.f;
#pragma unroll
                for (int bj = 0; bj < 2; ++bj) {
                    const size_t o = (size_t)row * D + col0 + bj * 128;
                    f32x4 b0, b1;
                    if (BASE_BF16) { const u32x4 bw = *(const u32x4*)(baseb + o); b0 = (f32x4){bflo(bw.x), bfhi(bw.x), bflo(bw.y), bfhi(bw.y)}; b1 = (f32x4){bflo(bw.z), bfhi(bw.z), bflo(bw.w), bfhi(bw.w)}; }
                    else { b0 = *(const f32x4*)(base + o); b1 = *(const f32x4*)(base + o + 4); }
                    const f32x4 v0 = acc[ai][bj][m][0] + b0, v1 = acc[ai][bj][m][1] + b1;
                    if (OUT_F32) { *(f32x4*)(out + o) = v0; *(f32x4*)(out + o + 4) = v1; }
                    if (OUT_BF16) { u32x4 w; w.x = pk2(v0[0], v0[1]); w.y = pk2(v0[2], v0[3]); w.z = pk2(v1[0], v1[1]); w.w = pk2(v1[2], v1[3]); *(u32x4*)(xn + o) = w; }
                    s += (v0[0] * v0[0] + v0[1] * v0[1]) + (v0[2] * v0[2] + v0[3] * v0[3]) + (v1[0] * v1[0] + v1[1] * v1[1]) + (v1[2] * v1[2] + v1[3] * v1[3]);
                }
                s += __shfl_xor(s, 16); s += __shfl_xor(s, 32);
                if (fq == 0) ss[(size_t)row * 16 + u.pn * 4 + wc] = s;
            }
    }
};
template <int ACT> struct EpiScale {
    static constexpr bool PERM = true, AFTER_DRAIN = false;
    bf16_t* O; int ldc; const float* ss; float scale;
    __device__ __forceinline__ void operator()(const f32x4 (&acc)[2][2][4][2], const pg8::Unit& u, int wr, int wc, int fr, int fq) const {
        const int row0 = u.pm * 256 + wr * 64 + fr; const int col0 = u.pn * 256 + wc * 32 + 8 * fq;
#pragma unroll
        for (int ai = 0; ai < 2; ++ai)
#pragma unroll
            for (int m = 0; m < 4; ++m) {
                const int row = row0 + ai * 128 + m * 16;
                const f32x4 s0 = *(const f32x4*)(ss + (size_t)row * 16), s1 = *(const f32x4*)(ss + (size_t)row * 16 + 4), s2 = *(const f32x4*)(ss + (size_t)row * 16 + 8), s3 = *(const f32x4*)(ss + (size_t)row * 16 + 12);
                const f32x4 st = (s0 + s1) + (s2 + s3);
                const float rstd = rsqrtf(((st[0] + st[1]) + (st[2] + st[3])) * (1.f / D) + EPS) * scale;
#pragma unroll
                for (int bj = 0; bj < 2; ++bj) {
                    f32x4 v0 = acc[ai][bj][m][0] * rstd, v1 = acc[ai][bj][m][1] * rstd;
                    if (ACT == 1) {
#pragma unroll
                        for (int j = 0; j < 4; ++j) { const float a = fmaxf(v0[j], 0.f), b = fmaxf(v1[j], 0.f); v0[j] = a * a; v1[j] = b * b; }
                    }
                    u32x4 w; w.x = pk2(v0[0], v0[1]); w.y = pk2(v0[2], v0[3]); w.z = pk2(v1[0], v1[1]); w.w = pk2(v1[2], v1[3]);
                    *(u32x4*)(O + (size_t)row * ldc + col0 + bj * 128) = w;
                }
            }
    }
};

__device__ __forceinline__ void p0_transpose_item(const float* __restrict__ W, int K, int N, bf16_t* WT, int dest_row0, const float* __restrict__ gk, LAS float* scr, int k0, int n0, int lane) {
#pragma unroll 8
    for (int i = 0; i < 32; ++i) { const int kk = 2 * i + (lane >> 5); float v = W[(size_t)(k0 + kk) * N + n0 + (lane & 31)]; if (gk) v *= gk[k0 + kk]; scr[kk * 33 + (lane & 31)] = v; }
    asm volatile("s_waitcnt lgkmcnt(0)" ::: "memory");
    const int c = lane & 7;
#pragma unroll
    for (int j = 0; j < 4; ++j) { const int n = (lane >> 3) + 8 * j; const LAS float* s = scr + (8 * c) * 33 + n;
        u32x4 o; o.x = pk2(s[0 * 33], s[1 * 33]); o.y = pk2(s[2 * 33], s[3 * 33]); o.z = pk2(s[4 * 33], s[5 * 33]); o.w = pk2(s[6 * 33], s[7 * 33]);
        *(u32x4*)(WT + (size_t)(dest_row0 + n) * K + k0 + 8 * c) = o; }
    asm volatile("s_waitcnt lgkmcnt(0)" ::: "memory");
}
__device__ __forceinline__ int win_dest_row(int n0) {
    if (n0 < 1536) return n0;
    const int cc = n0 - 1536, isg = cc >= 512, ch = cc & 511;
    return 1536 + 256 * (ch >> 7) + 128 * isg + (ch & 127);
}
__device__ __forceinline__ void rms_row_to_bf16(const float* xrow, const float* g, bf16_t* orow, int lane) {
    f32x4 v[4]; float s = 0.f;
#pragma unroll
    for (int j = 0; j < 4; ++j) { v[j] = *(const f32x4*)(xrow + 4 * lane + 256 * j); s += (v[j][0] * v[j][0] + v[j][1] * v[j][1]) + (v[j][2] * v[j][2] + v[j][3] * v[j][3]); }
    const float rstd = rsqrtf(wave_sum(s) * (1.f / D) + EPS);
#pragma unroll
    for (int j = 0; j < 4; ++j) { const f32x4 gg = *(const f32x4*)(g + 4 * lane + 256 * j); const f32x4 y = v[j] * rstd * gg;
        u32x2 w; w.x = pk2(y[0], y[1]); w.y = pk2(y[2], y[3]); *(u32x2*)(orow + 4 * lane + 256 * j) = w; }
}
__device__ __forceinline__ void p0_prologue(LAS unsigned char* lds, const Args& a, int tid) {
    const int lane = tid & 63, wave = __builtin_amdgcn_readfirstlane(tid >> 6);
    LAS float* scr = (LAS float*)(lds + wave * 16384);
    const int gw = blockIdx.x * 8 + wave, NGW = gridDim.x * 8;
    unsigned char* ws = a.ws;
    constexpr int I_IN = 16 * 80, I_SQ = 16 * 32;
    constexpr int NITEMS = I_IN + 2 * I_SQ;
    for (int it = gw; it < NITEMS; it += NGW) {
        int r = it;
        if (r < I_IN) { const int kb = r / 80, nb = r % 80; p0_transpose_item(a.in[3], D, DIN, (bf16_t*)(ws + WS_WIN), win_dest_row(32 * nb), nullptr, scr, 64 * kb, 32 * nb, lane); continue; } r -= I_IN;
        if (r < I_SQ) { p0_transpose_item(a.in[12], D, D, (bf16_t*)(ws + WS_WXKV), 32 * (r % 32), nullptr, scr, 64 * (r / 32), 32 * (r % 32), lane); continue; } r -= I_SQ;
        p0_transpose_item(a.in[13], D, D, (bf16_t*)(ws + WS_WXKV), 1024 + 32 * (r % 32), nullptr, scr, 64 * (r / 32), 32 * (r % 32), lane);
    }
    for (int m = gw; m < M; m += NGW) rms_row_to_bf16(a.in[0] + (size_t)m * D, a.in[2], (bf16_t*)(ws + WS_XN) + (size_t)m * D, lane);
    for (int m = gw; m < MM; m += NGW) rms_row_to_bf16(a.in[1] + (size_t)m * D, a.in[10], (bf16_t*)(ws + WS_MN) + (size_t)m * D, lane);
    float* CS = (float*)(ws + WS_CS);
    for (int idx = blockIdx.x * 512 + tid; idx < SEQ * 8; idx += gridDim.x * 512) {
        const int pos = idx >> 3, i = idx & 7;
        const float freq = powf(500000.0f, -(float)(2 * i) / 16.0f);
        const float ang = (float)pos * freq;
        CS[2 * idx] = cosf(ang); CS[2 * idx + 1] = sinf(ang);
    }
}

__device__ __forceinline__ void late_weights(LAS unsigned char* lds, const Args& a, int tid, int hw, int nh) {
    const int lane = tid & 63, wave = __builtin_amdgcn_readfirstlane(tid >> 6);
    LAS float* scr = (LAS float*)(lds + wave * 16384);
    const int gw = hw * 8 + wave, NGW = nh * 8;
    unsigned char* ws = a.ws;
    constexpr int I_SQ = 16 * 32, I_UP = 16 * 128, I_DN = 64 * 32;
    constexpr int NITEMS = 3 * I_SQ + I_UP + I_DN;
    for (int it = gw; it < NITEMS; it += NGW) {
        int r = it;
        if (r < I_SQ) { p0_transpose_item(a.in[8], D, D, (bf16_t*)(ws + WS_WOUT), 32 * (r % 32), nullptr, scr, 64 * (r / 32), 32 * (r % 32), lane); continue; } r -= I_SQ;
        if (r < I_SQ) { p0_transpose_item(a.in[11], D, D, (bf16_t*)(ws + WS_WXQ), 32 * (r % 32), a.in[9], scr, 64 * (r / 32), 32 * (r % 32), lane); continue; } r -= I_SQ;
        if (r < I_SQ) { p0_transpose_item(a.in[14], D, D, (bf16_t*)(ws + WS_WXO), 32 * (r % 32), nullptr, scr, 64 * (r / 32), 32 * (r % 32), lane); continue; } r -= I_SQ;
        if (r < I_UP) { p0_transpose_item(a.in[16], D, FF, (bf16_t*)(ws + WS_WUP), 32 * (r % 128), a.in[15], scr, 64 * (r / 128), 32 * (r % 128), lane); continue; } r -= I_UP;
        p0_transpose_item(a.in[17], FF, D, (bf16_t*)(ws + WS_WDN), 32 * (r % 32), nullptr, scr, 64 * (r / 32), 32 * (r % 32), lane);
    }
}

constexpr int KV_ROWS = 272, KV_PITCH = 144, KV_BYTES = KV_ROWS * KV_PITCH, KV_CHUNKS = KV_ROWS * 8;
constexpr int N_DATTN_UNITS = BATCH * 8 * 192;
struct DUnit { int h, d, L, r, j0, pat; size_t rowbase; };
__device__ __forceinline__ DUnit dattn_decode(int unit) {
    DUnit u; const int bh = unit / 192, rem = unit % 192, blk = rem % 64; u.pat = rem / 64;
    u.h = bh & 7; u.rowbase = (size_t)(bh >> 3) * SEQ;
    const int dsh = 2 * u.pat; u.d = 1 << dsh; u.L = SEQ >> dsh; const int nblk = u.L >> 7;
    u.r = blk / nblk; u.j0 = (blk % nblk) * 128; return u;
}
__device__ __forceinline__ void dattn_issue(const DUnit& u, const bf16_t* __restrict__ Qb, const bf16_t* __restrict__ Kb, const bf16_t* __restrict__ Vb, u32x4 (&kv)[9], bf16x8& qf0, bf16x8& qf1, int tid, int w, int ql, int g) {
#pragma unroll
    for (int i = 0; i < 9; ++i) {
        const int c = tid + 512 * i; const int which = c >= KV_CHUNKS; const int cc = which ? c - KV_CHUNKS : c; const int row = cc >> 3, ch = cc & 7; const int j = u.j0 - 64 + row;
        u32x4 v = {0u, 0u, 0u, 0u};
        if (c < 2 * KV_CHUNKS && j >= 0 && j < u.L) v = *(const u32x4*)((which ? Vb : Kb) + (u.rowbase + (size_t)j * u.d + u.r) * 512 + u.h * 64 + ch * 8);
        kv[i] = v;
    }
    const size_t qrow = u.rowbase + (size_t)(u.j0 + 16 * w + ql) * u.d + u.r;
    const bf16_t* qp = Qb + qrow * 512 + u.h * 64 + 8 * g;
    qf0 = *(const bf16x8*)qp; qf1 = *(const bf16x8*)(qp + 32);
}
__device__ __forceinline__ void dattn_compute(LAS unsigned char* lds, const DUnit& u, const bf16x8 qf0, const bf16x8 qf1, bf16_t* OP, float* LSE, int w, int ql, int g) {
    const int jq = u.j0 + 16 * w + ql; const size_t qrow = u.rowbase + (size_t)jq * u.d + u.r; const int L = u.L;
    f32x4 st[9];
    const LAS unsigned char* kp = lds + (16 * w + ql) * KV_PITCH + g * 16;
#pragma unroll
    for (int t = 0; t < 9; ++t) {
        const bf16x8 k0 = *(const LAS bf16x8*)(kp + t * 16 * KV_PITCH), k1 = *(const LAS bf16x8*)(kp + t * 16 * KV_PITCH + 64);
        f32x4 z = {0.f, 0.f, 0.f, 0.f};
        z = MFMA16(k0, qf0, z); st[t] = MFMA16(k1, qf1, z);
    }
    float mx = -1e30f;
#pragma unroll
    for (int t = 0; t < 9; ++t)
#pragma unroll
        for (int i = 0; i < 4; ++i) {
            const int diff = 16 * t + 4 * g + i - 64 - ql, jk = jq + diff;
            const bool valid = (diff >= -64) && (diff <= 64) && (jk >= 0) && (jk < L);
            const float s = valid ? st[t][i] : -1e30f; st[t][i] = s; mx = fmaxf(mx, s);
        }
    mx = fmaxf(mx, __shfl_xor(mx, 16)); mx = fmaxf(mx, __shfl_xor(mx, 32));
    float lsum = 0.f;
#pragma unroll
    for (int t = 0; t < 9; ++t)
#pragma unroll
        for (int i = 0; i < 4; ++i) { const float p = __builtin_amdgcn_exp2f(st[t][i] - mx); st[t][i] = p; lsum += p; }
    lsum += __shfl_xor(lsum, 16); lsum += __shfl_xor(lsum, 32);
    bf16x8 pf[5];
#pragma unroll
    for (int s = 0; s < 5; ++s) {
        u32x4 wv; wv.x = pk2(st[2 * s][0], st[2 * s][1]); wv.y = pk2(st[2 * s][2], st[2 * s][3]);
        if (2 * s + 1 < 9) { wv.z = pk2(st[(2 * s + 1) % 9][0], st[(2 * s + 1) % 9][1]); wv.w = pk2(st[(2 * s + 1) % 9][2], st[(2 * s + 1) % 9][3]); } else { wv.z = 0u; wv.w = 0u; }
        pf[s] = __builtin_bit_cast(bf16x8, wv);
    }
    f32x4 o[4];
#pragma unroll
    for (int dt = 0; dt < 4; ++dt) o[dt] = (f32x4){0.f, 0.f, 0.f, 0.f};
    const LAS unsigned char* vp = lds + KV_BYTES + (16 * w + 4 * g + (ql >> 2)) * KV_PITCH + (ql & 3) * 8;
#pragma unroll
    for (int s = 0; s < 5; ++s)
#pragma unroll
        for (int dt = 0; dt < 4; ++dt) {
            const s16x4 lo = vtr(vp + (32 * s) * KV_PITCH + dt * 32), hi = vtr(vp + (32 * s + 16) * KV_PITCH + dt * 32);
            const bf16x8 vf = {lo[0], lo[1], lo[2], lo[3], hi[0], hi[1], hi[2], hi[3]};
            o[dt] = MFMA16(vf, pf[s], o[dt]);
        }
    const float inv = __builtin_amdgcn_rcpf(lsum);
    bf16_t* op = OP + (size_t)u.pat * M * 512 + qrow * 512 + u.h * 64 + 4 * g;
#pragma unroll
    for (int dt = 0; dt < 4; ++dt) { u32x2 wv; wv.x = pk2(o[dt][0] * inv, o[dt][1] * inv); wv.y = pk2(o[dt][2] * inv, o[dt][3] * inv); *(u32x2*)(op + 16 * dt) = wv; }
    if (g == 0) LSE[(size_t)u.pat * M * 8 + qrow * 8 + u.h] = mx + __builtin_amdgcn_logf(lsum);
}
__device__ __forceinline__ void dattn_phase(LAS unsigned char* lds, const bf16_t* __restrict__ Qb, const bf16_t* __restrict__ Kb, const bf16_t* __restrict__ Vb, bf16_t* OP, float* LSE, int c0, int G, int tid) {
    const int lane = tid & 63, w = __builtin_amdgcn_readfirstlane(tid >> 6), ql = lane & 15, g = lane >> 4;
    int un = c0; if (un >= N_DATTN_UNITS) return;
    u32x4 kv[9]; bf16x8 qn0, qn1;
    DUnit cur = dattn_decode(un);
    dattn_issue(cur, Qb, Kb, Vb, kv, qn0, qn1, tid, w, ql, g);
#pragma unroll 1
    for (;;) {
#pragma unroll
        for (int i = 0; i < 9; ++i) {
            const int c = tid + 512 * i; const int which = c >= KV_CHUNKS; const int cc = which ? c - KV_CHUNKS : c; const int row = cc >> 3, ch = cc & 7;
            if (c < 2 * KV_CHUNKS) *(LAS u32x4*)(lds + which * KV_BYTES + row * KV_PITCH + ch * 16) = kv[i];
        }
        const bf16x8 q0 = qn0, q1 = qn1;
        __syncthreads();
        un += G; const bool has = un < N_DATTN_UNITS;
        DUnit nxt = cur;
        if (has) { nxt = dattn_decode(un); dattn_issue(nxt, Qb, Kb, Vb, kv, qn0, qn1, tid, w, ql, g); }
        dattn_compute(lds, cur, q0, q1, OP, LSE, w, ql, g);
        __syncthreads();
        if (!has) break;
        cur = nxt;
    }
}

constexpr int N_CONV_UNITS = M / 32;
__device__ __forceinline__ void conv_unit(LAS unsigned char* lds, const bf16_t* __restrict__ UC, const float* __restrict__ cw, const float* __restrict__ cb, const float* __restrict__ lg, const float* __restrict__ lb, bf16_t* MIX, int unit, int tid) {
    const int p0 = unit * 32, b = p0 >> 13, t0 = p0 & (SEQ - 1);
    LAS unsigned char* ut = lds; LAS float* ot = (LAS float*)(lds + 63488);
    {
        u32x4 tmp[8];
#pragma unroll
        for (int i = 0; i < 8; ++i) { const int c = tid + 512 * i; const int row = c >> 6, ch = c & 63, t = t0 - 15 + row;
            u32x4 v = {0u, 0u, 0u, 0u};
            if (c < 62 * 64 && t >= 0 && t < SEQ) v = *(const u32x4*)(UC + ((size_t)b * SEQ + t) * 512 + ch * 8);
            tmp[i] = v; }
#pragma unroll
        for (int i = 0; i < 8; ++i) { const int c = tid + 512 * i; const int row = c >> 6, ch = c & 63; if (c < 62 * 64) *(LAS u32x4*)(ut + row * 1024 + ch * 16) = tmp[i]; }
    }
    const int cp = tid & 255, half = tid >> 8;
    f32x2 wk[31];
#pragma unroll
    for (int k = 0; k < 31; ++k) wk[k] = *(const f32x2*)(cw + k * 512 + 2 * cp);
    const f32x2 bias = *(const f32x2*)(cb + 2 * cp);
    __syncthreads();
#pragma unroll 1
    for (int grp = 0; grp < 2; ++grp) {
        const int base = half * 16 + grp * 8;
        f32x2 acc[8];
#pragma unroll
        for (int o = 0; o < 8; ++o) acc[o] = bias;
#pragma unroll
        for (int i = 0; i < 38; ++i) {
            const unsigned xw = *(const LAS unsigned*)(ut + (base + i) * 1024 + cp * 4);
            const f32x2 x = {bflo(xw), bfhi(xw)};
#pragma unroll
            for (int o = 0; o < 8; ++o) { const int k = i - o; if (k >= 0 && k <= 30) acc[o] += wk[k < 0 ? 0 : (k > 30 ? 30 : k)] * x; }
        }
#pragma unroll
        for (int o = 0; o < 8; ++o) *(LAS f32x2*)(ot + (base + o) * 512 + 2 * cp) = acc[o];
    }
    __syncthreads();
    const int lane = tid & 63, w = tid >> 6;
    const f32x4 g0 = *(const f32x4*)(lg + 8 * lane), g1 = *(const f32x4*)(lg + 8 * lane + 4), b0 = *(const f32x4*)(lb + 8 * lane), b1 = *(const f32x4*)(lb + 8 * lane + 4);
#pragma unroll
    for (int pp = 0; pp < 4; ++pp) {
        const int pos = 4 * w + pp;
        const f32x4 x0 = *(const LAS f32x4*)(ot + pos * 512 + 8 * lane), x1 = *(const LAS f32x4*)(ot + pos * 512 + 8 * lane + 4);
        float s = (x0[0] + x0[1]) + (x0[2] + x0[3]) + (x1[0] + x1[1]) + (x1[2] + x1[3]);
        float s2 = (x0[0] * x0[0] + x0[1] * x0[1]) + (x0[2] * x0[2] + x0[3] * x0[3]) + (x1[0] * x1[0] + x1[1] * x1[1]) + (x1[2] * x1[2] + x1[3] * x1[3]);
        s = wave_sum(s); s2 = wave_sum(s2);
        const float mean = s * (1.f / 512.f), var = fmaxf(s2 * (1.f / 512.f) - mean * mean, 0.f), rstd = rsqrtf(var + EPS);
        float y[8];
#pragma unroll
        for (int j = 0; j < 4; ++j) { y[j] = (x0[j] - mean) * rstd * g0[j] + b0[j]; y[4 + j] = (x1[j] - mean) * rstd * g1[j] + b1[j]; }
#pragma unroll
        for (int j = 0; j < 8; ++j) y[j] = y[j] * __builtin_amdgcn_rcpf(1.f + __expf(-y[j]));
        u32x4 wv; wv.x = pk2(y[0], y[1]); wv.y = pk2(y[2], y[3]); wv.z = pk2(y[4], y[5]); wv.w = pk2(y[6], y[7]);
        *(u32x4*)(MIX + (size_t)(p0 + pos) * 1024 + 512 + 8 * lane) = wv;
    }
    __syncthreads();
}

__device__ __forceinline__ void merge_phase(const bf16_t* __restrict__ OP, const float* __restrict__ LSE, bf16_t* MIX, int tid) {
    for (int idx = blockIdx.x * 512 + tid; idx < M * 64; idx += gridDim.x * 512) {
        const int row = idx >> 6, hc = idx & 63, h = hc >> 3;
        const float l0 = LSE[(size_t)row * 8 + h], l1 = LSE[(size_t)M * 8 + (size_t)row * 8 + h], l2 = LSE[(size_t)2 * M * 8 + (size_t)row * 8 + h];
        const float mx = fmaxf(l0, fmaxf(l1, l2));
        float w0 = exp2f(l0 - mx), w1 = exp2f(l1 - mx), w2 = exp2f(l2 - mx);
        const float inv = 1.f / (w0 + w1 + w2); w0 *= inv; w1 *= inv; w2 *= inv;
        const u32x4 a0 = *(const u32x4*)(OP + (size_t)row * 512 + hc * 8), a1 = *(const u32x4*)(OP + (size_t)M * 512 + (size_t)row * 512 + hc * 8), a2 = *(const u32x4*)(OP + (size_t)2 * M * 512 + (size_t)row * 512 + hc * 8);
        u32x4 wv;
#pragma unroll
        for (int q = 0; q < 4; ++q) {
            const float lo = w0 * bflo(a0[q]) + w1 * bflo(a1[q]) + w2 * bflo(a2[q]);
            const float hi = w0 * bfhi(a0[q]) + w1 * bfhi(a1[q]) + w2 * bfhi(a2[q]);
            wv[q] = pk2(lo, hi);
        }
        *(u32x4*)(MIX + (size_t)row * 1024 + hc * 8) = wv;
    }
}

constexpr int XP = 528, XPV = 544;
constexpr int N_XATTN_UNITS = BATCH * 4 * (SEQ / 256);
__device__ __forceinline__ void xattn_unit(LAS unsigned char* lds, const bf16_t* __restrict__ XQ, const bf16_t* __restrict__ XK, const bf16_t* __restrict__ XV, bf16_t* XO, int unit, int tid) {
    const int lane = tid & 63, w = __builtin_amdgcn_readfirstlane(tid >> 6), ql = lane & 15, g = lane >> 4;
    const int b = unit >> 7, xh = (unit >> 5) & 3, qb = unit & 31;
#pragma unroll 1
    for (int hb = 0; hb < 2; ++hb) {
        u32x4 tmp[8];
#pragma unroll
        for (int i = 0; i < 8; ++i) { const int c = tid + 512 * (8 * hb + i); const int row = c >> 5, ch = c & 31; tmp[i] = *(const u32x4*)(XK + (size_t)(b * NMEM + row) * 1024 + xh * 256 + ch * 8); }
#pragma unroll
        for (int i = 0; i < 8; ++i) { const int c = tid + 512 * (8 * hb + i); const int row = c >> 5, ch = c & 31; *(LAS u32x4*)(lds + row * XP + ch * 16) = tmp[i]; }
    }
    const size_t qrow0 = (size_t)b * SEQ + qb * 256 + 32 * w + ql;
    bf16x8 qf[2][8];
#pragma unroll
    for (int qt = 0; qt < 2; ++qt)
#pragma unroll
        for (int ks = 0; ks < 8; ++ks) qf[qt][ks] = *(const bf16x8*)(XQ + (qrow0 + 16 * qt) * 1024 + xh * 256 + 32 * ks + 8 * g);
    __syncthreads();
    f32x4 st[16][2];
    const LAS unsigned char* kp = lds + ql * XP + g * 16;
#pragma unroll
    for (int t = 0; t < 16; ++t) {
        f32x4 z0 = {0.f, 0.f, 0.f, 0.f}, z1 = {0.f, 0.f, 0.f, 0.f};
#pragma unroll
        for (int ks = 0; ks < 8; ++ks) { const bf16x8 kf = *(const LAS bf16x8*)(kp + t * 16 * XP + ks * 64); z0 = MFMA16(kf, qf[0][ks], z0); z1 = MFMA16(kf, qf[1][ks], z1); }
        st[t][0] = z0; st[t][1] = z1;
    }
    float inv[2];
    bf16x8 pf[2][8];
#pragma unroll
    for (int qt = 0; qt < 2; ++qt) {
        float mx = -1e30f;
#pragma unroll
        for (int t = 0; t < 16; ++t)
#pragma unroll
            for (int i = 0; i < 4; ++i) mx = fmaxf(mx, st[t][qt][i]);
        mx = fmaxf(mx, __shfl_xor(mx, 16)); mx = fmaxf(mx, __shfl_xor(mx, 32));
        float lsum = 0.f;
#pragma unroll
        for (int t = 0; t < 16; ++t)
#pragma unroll
            for (int i = 0; i < 4; ++i) { const float p = __builtin_amdgcn_exp2f(st[t][qt][i] - mx); st[t][qt][i] = p; lsum += p; }
        lsum += __shfl_xor(lsum, 16); lsum += __shfl_xor(lsum, 32);
        inv[qt] = __builtin_amdgcn_rcpf(lsum);
#pragma unroll
        for (int s = 0; s < 8; ++s) {
            u32x4 wv; wv.x = pk2(st[2 * s][qt][0], st[2 * s][qt][1]); wv.y = pk2(st[2 * s][qt][2], st[2 * s][qt][3]);
            wv.z = pk2(st[2 * s + 1][qt][0], st[2 * s + 1][qt][1]); wv.w = pk2(st[2 * s + 1][qt][2], st[2 * s + 1][qt][3]);
            pf[qt][s] = __builtin_bit_cast(bf16x8, wv);
        }
    }
    __syncthreads();
#pragma unroll 1
    for (int hb = 0; hb < 2; ++hb) {
        u32x4 tmp[8];
#pragma unroll
        for (int i = 0; i < 8; ++i) { const int c = tid + 512 * (8 * hb + i); const int row = c >> 5, ch = c & 31; tmp[i] = *(const u32x4*)(XV + (size_t)(b * NMEM + row) * 1024 + xh * 256 + ch * 8); }
#pragma unroll
        for (int i = 0; i < 8; ++i) { const int c = tid + 512 * (8 * hb + i); const int row = c >> 5, ch = c & 31; *(LAS u32x4*)(lds + row * XPV + ch * 16) = tmp[i]; }
    }
    __syncthreads();
    const LAS unsigned char* vp = lds + (4 * g + (ql >> 2)) * XPV + (ql & 3) * 8;
#pragma unroll
    for (int hf = 0; hf < 2; ++hf) {
        f32x4 o[8][2];
#pragma unroll
        for (int dd = 0; dd < 8; ++dd) { o[dd][0] = (f32x4){0.f, 0.f, 0.f, 0.f}; o[dd][1] = (f32x4){0.f, 0.f, 0.f, 0.f}; }
#pragma unroll
        for (int s = 0; s < 8; ++s)
#pragma unroll
            for (int dd = 0; dd < 8; ++dd) {
                const int dt = hf * 8 + dd;
                const s16x4 lo = vtr(vp + (32 * s) * XPV + dt * 32), hi = vtr(vp + (32 * s + 16) * XPV + dt * 32);
                const bf16x8 vf = {lo[0], lo[1], lo[2], lo[3], hi[0], hi[1], hi[2], hi[3]};
                o[dd][0] = MFMA16(vf, pf[0][s], o[dd][0]); o[dd][1] = MFMA16(vf, pf[1][s], o[dd][1]);
            }
#pragma unroll
        for (int qt = 0; qt < 2; ++qt)
#pragma unroll
            for (int dd = 0; dd < 8; ++dd) {
                u32x2 wv; wv.x = pk2(o[dd][qt][0] * inv[qt], o[dd][qt][1] * inv[qt]); wv.y = pk2(o[dd][qt][2] * inv[qt], o[dd][qt][3] * inv[qt]);
                *(u32x2*)(XO + (qrow0 + 16 * qt) * 1024 + xh * 256 + 16 * (hf * 8 + dd) + 4 * g) = wv;
            }
    }
    __syncthreads();
}

__device__ __forceinline__ void final_phase(float* out, const bf16_t* __restrict__ hb, const float* __restrict__ ss, const float* __restrict__ gfin, int tid) {
    const int lane = tid & 63, wave = tid >> 6;
    for (int row = blockIdx.x * 8 + wave; row < M; row += gridDim.x * 8) {
        float s = ss[(size_t)row * 16 + (lane & 15)];
        s += __shfl_xor(s, 1); s += __shfl_xor(s, 2); s += __shfl_xor(s, 4); s += __shfl_xor(s, 8);
        const float rstd = rsqrtf(s * (1.f / D) + EPS);
#pragma unroll
        for (int j = 0; j < 2; ++j) {
            const int col = 8 * lane + 512 * j;
            const u32x4 w = *(const u32x4*)(hb + (size_t)row * D + col);
            const f32x4 g0 = *(const f32x4*)(gfin + col), g1 = *(const f32x4*)(gfin + col + 4);
            const f32x4 v0 = {bflo(w.x), bfhi(w.x), bflo(w.y), bfhi(w.y)}, v1 = {bflo(w.z), bfhi(w.z), bflo(w.w), bfhi(w.w)};
            *(f32x4*)(out + (size_t)row * D + col) = v0 * rstd * g0; *(f32x4*)(out + (size_t)row * D + col + 4) = v1 * rstd * g1;
        }
    }
}

#define XB_TMO      128
#define XB_XCNT(j)  (256  + 64 * (j))
#define XB_XSUB(j)  (1280 + 64 * (j))
#define XB_XGEN(j)  (2304 + 64 * (j))
#define XB_TOP      3328
#define XB_TOPGEN   3392
#define XCD_BAR_WORDS 3456
#define XB_SPIN_CAP (1u << 18)

__device__ __forceinline__ unsigned xb_ld(unsigned* p)              { return __hip_atomic_load(p, __ATOMIC_RELAXED, __HIP_MEMORY_SCOPE_AGENT); }
__device__ __forceinline__ unsigned xb_add(unsigned* p, unsigned v) { return __hip_atomic_fetch_add(p, v, __ATOMIC_RELAXED, __HIP_MEMORY_SCOPE_AGENT); }
__device__ __forceinline__ unsigned xb_xcc_id() { return (unsigned)__builtin_amdgcn_s_getreg((3 << 11) | 20) & 0xFu; }
#define XB_SPIN(cond, bar) do { unsigned _sp = 0; while (cond) { __builtin_amdgcn_s_sleep(1); \
    if ((++_sp & 255u) == 0u) { if (xb_ld(&(bar)[XB_TMO])) break; if (_sp > XB_SPIN_CAP) { atomicAdd(&(bar)[XB_TMO], 1u); break; } } } } while (0)

struct XcdBarrier {
    unsigned* bar; unsigned x;
    volatile LAS unsigned* st;
};

__device__ __forceinline__ XcdBarrier xcd_barrier_post(unsigned* bar, volatile LAS unsigned* st) {
    XcdBarrier b; b.bar = bar; b.x = xb_xcc_id(); b.st = st;
    if (threadIdx.x == 0) (void)xb_add(&bar[XB_XCNT(b.x)], 1u);
    return b;
}
__device__ __forceinline__ void xcd_barrier_complete(unsigned* bar, unsigned x, unsigned& nloc, unsigned& nx) {
    const unsigned G = gridDim.x * gridDim.y * gridDim.z;
    unsigned sum, cnt, mine, sp = 0u;
    for (;;) {
        sum = 0u; cnt = 0u; mine = 0u;
#pragma unroll
        for (unsigned j = 0; j < 16; ++j) { const unsigned c = xb_ld(&bar[XB_XCNT(j)]); sum += c; cnt += (c > 0u) ? 1u : 0u; mine = (j == x) ? c : mine; }
        if (sum == G) break;
        __builtin_amdgcn_s_sleep(1);
        if ((++sp & 255u) == 0u) { if (xb_ld(&bar[XB_TMO])) break; if (sp > XB_SPIN_CAP) { atomicAdd(&bar[XB_TMO], 1u); break; } }
    }
    nloc = mine > 0u ? mine : 1u; nx = cnt > 0u ? cnt : 1u;
}

__device__ __forceinline__ void xcd_barrier(const XcdBarrier& b) {
    asm volatile("s_waitcnt vmcnt(0)" ::: "memory");
    __syncthreads();
    if (threadIdx.x == 0) {
        unsigned* bar = b.bar;
        __builtin_amdgcn_s_waitcnt(0);
        unsigned nloc = b.st[0], nx = b.st[1];
        if (nloc == 0u) { xcd_barrier_complete(bar, b.x, nloc, nx); b.st[0] = nloc; b.st[1] = nx; }
        const unsigned old = xb_add(&bar[XB_XSUB(b.x)], 1u);
        const unsigned gen = old / nloc;
        if (old + 1u == (gen + 1u) * nloc) {
            __builtin_amdgcn_fence(__ATOMIC_RELEASE, "agent");
            asm volatile("s_waitcnt vmcnt(0)" ::: "memory");
            const unsigned og = xb_add(&bar[XB_TOP], 1u);
            const unsigned tg = og / nx;
            if (og + 1u == (tg + 1u) * nx) xb_add(&bar[XB_TOPGEN], 1u);
            else XB_SPIN(xb_ld(&bar[XB_TOPGEN]) == tg, bar);
            __builtin_amdgcn_fence(__ATOMIC_ACQUIRE, "agent");
            xb_add(&bar[XB_XGEN(b.x)], 1u);
            asm volatile("s_waitcnt vmcnt(0)" ::: "memory");
        } else {
            XB_SPIN(xb_ld(&bar[XB_XGEN(b.x)]) == gen, bar);
            __builtin_amdgcn_fence(__ATOMIC_ACQUIRE, "agent");
            asm volatile("s_waitcnt vmcnt(0)" ::: "memory");
        }
    }
    __syncthreads();
}


__global__ void __launch_bounds__(512, 2) fwd_megakernel(Args a) {
    extern __shared__ __attribute__((aligned(16))) unsigned char lds_raw[];
    LAS unsigned char* lds = (LAS unsigned char*)lds_raw;
    const int tid = threadIdx.x;
    unsigned char* ws = a.ws;
    const int lo = a.ph_lo, hi = a.ph_hi;
    const int G = gridDim.x, c = blockIdx.x;
    bf16_t* XN = (bf16_t*)(ws + WS_XN);
    volatile LAS unsigned* bst = (volatile LAS unsigned*)(lds + LDS_BYTES - 64);
    if (tid == 0) { bst[0] = 0u; bst[1] = 0u; }
    __syncthreads();
    XcdBarrier bar = xcd_barrier_post((unsigned*)ws, bst);
    if (a.ph_hi < 0) cg::this_grid().sync();
#define IN(k) (lo <= (k) && (k) < hi)
#define SEAM(k) do { if (IN(k) && IN((k) + 1)) xcd_barrier(bar); } while (0)

#ifndef PROBE_P0
#define PROBE_P0 0
#define PROBE_P2 0
#define PROBE_P6 0
#define PROBE_SYNC 0
#define PROBE_P3 0
#endif
    if (IN(0)) p0_prologue(lds, a, tid);
#if PROBE_P0
    if (IN(0)) p0_prologue(lds, a, tid);
#endif
    #if PROBE_SYNC
    _Pragma("unroll 1") for (int rep = 0; rep < PROBE_SYNC; ++rep) xcd_barrier(bar);
#endif
    SEAM(0);
    if (IN(1)) {
        { pg8::Gemm g{XN, (const bf16_t*)(ws + WS_WIN), M, DIN, D}; pg8::StaticOrder S; S.init(M, DIN, G, c);
          EpiIn E{(bf16_t*)(ws + WS_QB), (bf16_t*)(ws + WS_KB), (bf16_t*)(ws + WS_VB), (bf16_t*)(ws + WS_UC), (const float*)(ws + WS_CS)};
          pg8::gemm_phase<EpiIn, pg8::StaticOrder, true, true>(lds, g, S, E); }
        { const int c2 = (c + G - (640 % G)) % G;
          pg8::Gemm g{(const bf16_t*)(ws + WS_MN), (const bf16_t*)(ws + WS_WXKV), MM, 2048, D}; pg8::StaticOrder S; S.init(MM, 2048, G, c2);
          EpiKV E{(bf16_t*)(ws + WS_XK), (bf16_t*)(ws + WS_XV)};
          pg8::gemm_phase<EpiKV, pg8::StaticOrder, true, true>(lds, g, S, E);
          const int nidle = (G == 256) ? 112 : G; const int hw = (G == 256) ? c2 - 16 : c;
          if (hw >= 0 && hw < nidle) { __syncthreads(); late_weights(lds, a, tid, hw, nidle); } }
    }
    SEAM(1);
    if (IN(2)) {
        dattn_phase(lds, (const bf16_t*)(ws + WS_QB), (const bf16_t*)(ws + WS_KB), (const bf16_t*)(ws + WS_VB), (bf16_t*)(ws + WS_OP), (float*)(ws + WS_LSE), c, G, tid);
        for (int u = c; u < N_CONV_UNITS; u += G) conv_unit(lds, (const bf16_t*)(ws + WS_UC), a.in[4], a.in[5], a.in[6], a.in[7], (bf16_t*)(ws + WS_MIX), u, tid);
    }
    #if PROBE_P2
    __syncthreads();
if (IN(2)) {
        dattn_phase(lds, (const bf16_t*)(ws + WS_QB), (const bf16_t*)(ws + WS_KB), (const bf16_t*)(ws + WS_VB), (bf16_t*)(ws + WS_OP), (float*)(ws + WS_LSE), c, G, tid);
        for (int u = c; u < N_CONV_UNITS; u += G) conv_unit(lds, (const bf16_t*)(ws + WS_UC), a.in[4], a.in[5], a.in[6], a.in[7], (bf16_t*)(ws + WS_MIX), u, tid);
    }
    #endif
    SEAM(2);
    if (IN(3)) merge_phase((const bf16_t*)(ws + WS_OP), (const float*)(ws + WS_LSE), (bf16_t*)(ws + WS_MIX), tid);
    #if PROBE_P3
if (IN(3)) merge_phase((const bf16_t*)(ws + WS_OP), (const float*)(ws + WS_LSE), (bf16_t*)(ws + WS_MIX), tid);
    #endif
    SEAM(3);
    if (IN(4)) { pg8::Gemm g{(const bf16_t*)(ws + WS_MIX), (const bf16_t*)(ws + WS_WOUT), M, D, D}; pg8::StaticOrder S; S.init(M, D, G, c);
        EpiRes<false, false, true> E{a.in[0], nullptr, nullptr, XN, (float*)(ws + WS_SS1)};
        pg8::gemm_phase<EpiRes<false, false, true>, pg8::StaticOrder, true, true>(lds, g, S, E); }
    SEAM(4);
    if (IN(5)) { pg8::Gemm g{XN, (const bf16_t*)(ws + WS_WXQ), M, D, D}; pg8::StaticOrder S; S.init(M, D, G, c);
        EpiScale<0> E{(bf16_t*)(ws + WS_XQ), D, (const float*)(ws + WS_SS1), XQSCALE};
        pg8::gemm_phase<EpiScale<0>, pg8::StaticOrder, true, true>(lds, g, S, E); }
    SEAM(5);
    if (IN(6)) { for (int u = c; u < N_XATTN_UNITS; u += G) xattn_unit(lds, (const bf16_t*)(ws + WS_XQ), (const bf16_t*)(ws + WS_XK), (const bf16_t*)(ws + WS_XV), (bf16_t*)(ws + WS_XO), u, tid); }
    #if PROBE_P6
if (IN(6)) { for (int u = c; u < N_XATTN_UNITS; u += G) xattn_unit(lds, (const bf16_t*)(ws + WS_XQ), (const bf16_t*)(ws + WS_XK), (const bf16_t*)(ws + WS_XV), (bf16_t*)(ws + WS_XO), u, tid); }
    #endif
    SEAM(6);
    if (IN(7)) { pg8::Gemm g{(const bf16_t*)(ws + WS_XO), (const bf16_t*)(ws + WS_WXO), M, D, D}; pg8::StaticOrder S; S.init(M, D, G, c);
        EpiRes<true, false, true> E{nullptr, XN, nullptr, XN, (float*)(ws + WS_SS2)};
        pg8::gemm_phase<EpiRes<true, false, true>, pg8::StaticOrder, true, true>(lds, g, S, E); }
    SEAM(7);
    if (IN(8)) { pg8::Gemm g{XN, (const bf16_t*)(ws + WS_WUP), M, FF, D}; pg8::StaticOrder S; S.init(M, FF, G, c);
        EpiScale<1> E{(bf16_t*)(ws + WS_U), FF, (const float*)(ws + WS_SS2), 1.f};
        pg8::gemm_phase<EpiScale<1>, pg8::StaticOrder, true, true>(lds, g, S, E); }
    SEAM(8);
    if (IN(9)) { pg8::Gemm g{(const bf16_t*)(ws + WS_U), (const bf16_t*)(ws + WS_WDN), M, D, FF}; pg8::StaticOrder S; S.init(M, D, G, c);
        EpiRes<true, false, true> E{nullptr, XN, nullptr, XN, (float*)(ws + WS_SS3)};
        pg8::gemm_phase<EpiRes<true, false, true>, pg8::StaticOrder, true, true>(lds, g, S, E); }
    SEAM(9);
    if (IN(10)) final_phase(a.out, XN, (const float*)(ws + WS_SS3), a.in[18], tid);
#undef IN
#undef SEAM
}

#ifndef MK_SPLIT
#define MK_SPLIT 0
#endif
extern "C" void kernel_launch(void* const* d_in, const int* in_sizes, int n_in, void* d_out, int out_size, void* d_ws, size_t ws_size, hipStream_t stream) {
    static int grid = 0;
    if (grid == 0) {
        int dev = 0, cus = 0, per_cu = 0;
        hipGetDevice(&dev);
        hipDeviceGetAttribute(&cus, hipDeviceAttributeMultiprocessorCount, dev);
        if (hipFuncSetAttribute((const void*)fwd_megakernel, hipFuncAttributeMaxDynamicSharedMemorySize, LDS_BYTES) != hipSuccess) fprintf(stderr, "kernel_launch: hipFuncSetAttribute failed\n");
        if (hipOccupancyMaxActiveBlocksPerMultiprocessor(&per_cu, (const void*)fwd_megakernel, 512, LDS_BYTES) != hipSuccess || per_cu < 1) { fprintf(stderr, "kernel_launch: occupancy query says %d\n", per_cu); per_cu = 1; }
        (void)hipGetLastError();
        grid = cus > 0 ? cus : 256;
        if (n_in != 19 || ws_size < WS_END) fprintf(stderr, "kernel_launch: unexpected n_in %d / ws_size %zu\n", n_in, ws_size);
    }
    Args a{};
    for (int i = 0; i < 19; ++i) a.in[i] = (const float*)d_in[i];
    a.out = (float*)d_out; a.ws = (unsigned char*)d_ws;
#if MK_SPLIT
    for (int p = 0; p < NPH; ++p) { a.ph_lo = p; a.ph_hi = p + 1; hipLaunchKernelGGL(fwd_megakernel, dim3(grid), dim3(512), LDS_BYTES, stream, a); }
#else
    a.ph_lo = 0; a.ph_hi = NPH;
    if (hipMemsetAsync(d_ws, 0, 16384, stream) != hipSuccess) fprintf(stderr, "kernel_launch: memset of the barrier words failed\n");
    void* args[] = {&a};
    hipError_t e = hipLaunchCooperativeKernel((const void*)fwd_megakernel, dim3(grid), dim3(512), args, LDS_BYTES, stream);
    if (e != hipSuccess) fprintf(stderr, "kernel_launch: cooperative launch failed: %s (grid %d)\n", hipGetErrorString(e), grid);
#endif
}
```

```cpp
#include <hip/hip_runtime.h>
#include <hip/hip_cooperative_groups.h>
#include <cstdio>
#include <cstdint>
namespace cg = cooperative_groups;
namespace pg8 {
#define PG8_LAS __attribute__((address_space(3)))
typedef unsigned short bf16_t;
typedef short bf16x8 __attribute__((ext_vector_type(8)));
typedef float f32x4 __attribute__((ext_vector_type(4)));
typedef unsigned u32x4 __attribute__((ext_vector_type(4)));
constexpr int BM = 256, BK = 64, HALF = 128, HTB = HALF * BK * 2  , STAGE_BYTES = 8 * HTB, NXCD = 8, WGM = 8;

__host__ __device__ __forceinline__ int lds_byte(int r, int c) { const int st = (r >> 4) * 2 + (c >> 5), rr = r & 15, cc = c & 31, ob = rr * 64 + cc * 2; return st * 1024 + (ob ^ (((ob >> 9) & 1) << 5)); }
__host__ __device__ __forceinline__ void stage_rc(int b, int& R, int& C) { const int st = b / 1024, sb = b % 1024, swz = sb ^ (((sb >> 9) & 1) << 5); R = (st >> 1) * 16 + swz / 64; C = (st & 1) * 32 + (swz % 64) / 2; }
__host__ __device__ __forceinline__ int perm32(int rho) { const int n = rho >> 4, i = rho & 15; return 8 * (i >> 2) + 4 * n + (i & 3); }

struct Unit { int pm, pn; };
struct Gemm { const bf16_t* A; const bf16_t* Bt; int M, N, K; };

struct StaticOrder {
    int nM, nN, nwg, G, c;
    __host__ __device__ void init(int M, int N, int G_, int c_) { nM = M / BM; nN = N / BM; nwg = nM * nN; G = G_; c = c_; }
    __host__ __device__ bool next(int i, Unit& u) const {
        const long L = (long)i * G + c; if (L >= nwg) return false;
        int wgid = (int)L; { const int q = nwg / NXCD, r = nwg % NXCD, xcd = wgid % NXCD, off = wgid / NXCD; wgid = (xcd < r ? xcd * (q + 1) : r * (q + 1) + (xcd - r) * q) + off; }
        const int nig = WGM * nN, gid = wgid / nig, fm = gid * WGM, gsz = (nM - fm) < WGM ? (nM - fm) : WGM;
        u.pm = fm + ((wgid % nig) % gsz); u.pn = (wgid % nig) / gsz; return true;
    }
    __device__ __forceinline__ void a_ready(const Unit&) const {}
    __device__ __forceinline__ void done(const Unit&) const {}
};
__device__ __forceinline__ unsigned cvt_pk_bf16(float lo, float hi) { unsigned r; asm volatile("v_cvt_pk_bf16_f32 %0, %1, %2" : "=v"(r) : "v"(lo), "v"(hi)); return r; }
template <class Epi, class Sched, bool ALIGN_EPI = false, bool SP2 = false>
__device__ __forceinline__ void gemm_phase(PG8_LAS unsigned char* lds, const Gemm g, const Sched& S, const Epi& E) {
    const int tid = threadIdx.x, wid = __builtin_amdgcn_readfirstlane(tid >> 6), lane = tid & 63, wr = wid >> 2, wc = wid & 3, fr = lane & 15, fq = lane >> 4;
    const int K = g.K, nt = K / BK;
    unsigned voffA[2], voffB[2];
#pragma unroll
    for (int i = 0; i < 2; ++i) { int R, C; stage_rc(tid * 16 + i * 8192, R, C); const int Rb = Epi::PERM ? ((R & ~31) + perm32(R & 31)) : R;
        voffA[i] = (unsigned)(R * K + C) * 2u; voffB[i] = (unsigned)(Rb * K + C) * 2u; }
    const size_t kstep = (size_t)(BK * 2);
    const size_t hstep = (size_t)HALF * K * 2;
    const size_t tstep = 2 * hstep;
    const unsigned ldsw = (unsigned)wid * 1024u;
    const int aoff = lds_byte(wr * 64 + fr, fq * 8), boff = lds_byte(wc * 32 + fr, fq * 8);
#define PG8_SA(b, h) (((b) * 2 + (h)) * HTB)
#define PG8_SB(b, h) ((4 + (b) * 2 + (h)) * HTB)
#define PG8_STAGE(bufoff, gbase, voff) do { _Pragma("unroll") for (int _i = 0; _i < 2; ++_i) \
        __builtin_amdgcn_global_load_lds((const unsigned*)((const char*)(gbase) + (voff)[_i]), (PG8_LAS unsigned*)(lds + (bufoff) + ldsw + _i * 8192), 16, 0, 0); } while (0)
#define PG8_LDA(dst, b, h) do { _Pragma("unroll") for (int m = 0; m < 4; ++m) _Pragma("unroll") for (int k = 0; k < 2; ++k) dst[m][k] = *(const PG8_LAS bf16x8*)(lds + PG8_SA(b, h) + aoff + m * 2048 + k * 1024); } while (0)
#define PG8_LDB(dst, b, h) do { _Pragma("unroll") for (int n = 0; n < 2; ++n) _Pragma("unroll") for (int k = 0; k < 2; ++k) dst[n][k] = *(const PG8_LAS bf16x8*)(lds + PG8_SB(b, h) + boff + n * 2048 + k * 1024); } while (0)
#define PG8_MMA(ai, bj, At, Bt) do { __builtin_amdgcn_s_setprio(1); _Pragma("unroll") for (int m = 0; m < 4; ++m) _Pragma("unroll") for (int n = 0; n < 2; ++n) _Pragma("unroll") for (int k = 0; k < 2; ++k) \
        acc[ai][bj][m][n] = __builtin_amdgcn_mfma_f32_16x16x32_bf16(Bt[n][k], At[m][k], acc[ai][bj][m][n], 0, 0, 0); __builtin_amdgcn_s_setprio(0); } while (0)
#define PG8_WAIT_V(n) asm volatile("s_waitcnt vmcnt(" #n ")" ::: "memory")
#define PG8_WAIT_L(n) asm volatile("s_waitcnt lgkmcnt(" #n ")" ::: "memory")
#define PG8_BAR __builtin_amdgcn_s_barrier()
#define PG8_SCHED __builtin_amdgcn_sched_barrier(0)
    Unit cur, nxt; int ui = 0;
    if (!S.next(0, cur)) return;
    f32x4 acc[2][2][4][2];
#pragma unroll
    for (int a = 0; a < 2; ++a)
#pragma unroll
        for (int b = 0; b < 2; ++b)
#pragma unroll
            for (int m = 0; m < 4; ++m)
#pragma unroll
                for (int n = 0; n < 2; ++n) acc[a][b][m][n] = (f32x4){0.f, 0.f, 0.f, 0.f};
    bf16x8 At[4][2], B0[2][2], B1[2][2];
    const char* cA = (const char*)g.A + (size_t)cur.pm * tstep; const char* cB = (const char*)g.Bt + (size_t)cur.pn * tstep;
    S.a_ready(cur);
    if constexpr (SP2) {
        PG8_STAGE(PG8_SB(0, 0), cB, voffB); PG8_STAGE(PG8_SB(0, 1), cB + hstep, voffB); PG8_STAGE(PG8_SA(0, 0), cA, voffA); PG8_STAGE(PG8_SA(0, 1), cA + hstep, voffA);
        if (wr == 1) PG8_BAR;
        PG8_WAIT_V(2); PG8_BAR;
        PG8_STAGE(PG8_SB(1, 0), cB + kstep, voffB); PG8_STAGE(PG8_SA(1, 0), cA + kstep, voffA); PG8_STAGE(PG8_SB(1, 1), cB + hstep + kstep, voffB);
        PG8_WAIT_V(6); PG8_BAR;
    } else {
        PG8_STAGE(PG8_SB(0, 0), cB, voffB); PG8_STAGE(PG8_SA(0, 0), cA, voffA); PG8_STAGE(PG8_SB(0, 1), cB + hstep, voffB); PG8_STAGE(PG8_SA(0, 1), cA + hstep, voffA);
        if (wr == 1) PG8_BAR;
        PG8_WAIT_V(4); PG8_BAR;
        PG8_STAGE(PG8_SB(1, 0), cB + kstep, voffB); PG8_STAGE(PG8_SA(1, 0), cA + kstep, voffA); PG8_STAGE(PG8_SB(1, 1), cB + hstep + kstep, voffB);
        PG8_WAIT_V(6); PG8_BAR;
    }
    for (;;) {
        const bool has_next = S.next(ui + 1, nxt);
        const char* nA = has_next ? (const char*)g.A + (size_t)nxt.pm * tstep : cA; const char* nB = has_next ? (const char*)g.Bt + (size_t)nxt.pn * tstep : cB;
        for (int t = 0; t < nt; t += 2) {
            const bool last = (t == nt - 2);
            const char* a1 = cA + (size_t)(t + 1) * kstep;
            const char* a2 = last ? nA : cA + (size_t)(t + 2) * kstep; const char* b2 = last ? nB : cB + (size_t)(t + 2) * kstep;
            const char* a3 = a2 + kstep; const char* b3 = b2 + kstep;
            if (last && has_next) S.a_ready(nxt);
            if constexpr (SP2) {
            PG8_LDB(B0, 0, 0); PG8_LDB(B1, 0, 1); PG8_SCHED; PG8_LDA(At, 0, 0); PG8_STAGE(PG8_SA(1, 1), a1 + hstep, voffA);
            PG8_WAIT_V(8); PG8_WAIT_L(0); PG8_BAR; PG8_MMA(0, 0, At, B0); PG8_MMA(0, 1, At, B1); PG8_BAR; PG8_SCHED;
            PG8_LDA(At, 0, 1); PG8_STAGE(PG8_SB(0, 0), b2, voffB); PG8_STAGE(PG8_SB(0, 1), b2 + hstep, voffB); PG8_STAGE(PG8_SA(0, 0), a2, voffA);
            PG8_WAIT_V(8); PG8_WAIT_L(0); PG8_BAR; PG8_MMA(1, 0, At, B0); PG8_MMA(1, 1, At, B1); PG8_BAR; PG8_SCHED;
            PG8_LDB(B0, 1, 0); PG8_LDB(B1, 1, 1); PG8_SCHED; PG8_LDA(At, 1, 0); PG8_STAGE(PG8_SA(0, 1), a2 + hstep, voffA);
            PG8_WAIT_V(8); PG8_WAIT_L(0); PG8_BAR; PG8_MMA(0, 0, At, B0); PG8_MMA(0, 1, At, B1); PG8_BAR; PG8_SCHED;
            PG8_LDA(At, 1, 1); PG8_STAGE(PG8_SB(1, 0), b3, voffB); PG8_STAGE(PG8_SB(1, 1), b3 + hstep, voffB); PG8_STAGE(PG8_SA(1, 0), a3, voffA);
            PG8_WAIT_V(8); PG8_WAIT_L(0); PG8_BAR; PG8_MMA(1, 0, At, B0); PG8_MMA(1, 1, At, B1); PG8_BAR; PG8_SCHED;
            } else {
            PG8_LDB(B0, 0, 0); PG8_SCHED; PG8_LDA(At, 0, 0); PG8_STAGE(PG8_SA(1, 1), a1 + hstep, voffA);
            PG8_WAIT_L(8); PG8_BAR; PG8_WAIT_L(0); PG8_MMA(0, 0, At, B0); PG8_BAR; PG8_SCHED;
            PG8_LDB(B1, 0, 1); PG8_STAGE(PG8_SB(0, 0), b2, voffB);
            PG8_BAR; PG8_WAIT_L(0); PG8_MMA(0, 1, At, B1); PG8_BAR;
            PG8_LDA(At, 0, 1); PG8_STAGE(PG8_SA(0, 0), a2, voffA);
            PG8_BAR; PG8_WAIT_L(0); PG8_MMA(1, 0, At, B0); PG8_BAR; PG8_SCHED;
            PG8_STAGE(PG8_SB(0, 1), b2 + hstep, voffB);
            PG8_WAIT_V(6); PG8_BAR; PG8_MMA(1, 1, At, B1); PG8_BAR;
            PG8_LDB(B0, 1, 0); PG8_SCHED; PG8_LDA(At, 1, 0); PG8_STAGE(PG8_SA(0, 1), a2 + hstep, voffA);
            PG8_WAIT_L(8); PG8_BAR; PG8_WAIT_L(0); PG8_MMA(0, 0, At, B0); PG8_BAR; PG8_SCHED;
            PG8_LDB(B1, 1, 1); PG8_STAGE(PG8_SB(1, 0), b3, voffB);
            PG8_BAR; PG8_WAIT_L(0); PG8_MMA(0, 1, At, B1); PG8_BAR;
            PG8_LDA(At, 1, 1); PG8_STAGE(PG8_SA(1, 0), a3, voffA);
            PG8_BAR; PG8_WAIT_L(0); PG8_MMA(1, 0, At, B0); PG8_BAR; PG8_SCHED;
            PG8_STAGE(PG8_SB(1, 1), b3 + hstep, voffB);
            PG8_WAIT_V(6); PG8_BAR; PG8_MMA(1, 1, At, B1); PG8_BAR;
            }
        }
        if constexpr (ALIGN_EPI) { if (wr == 0) PG8_BAR; }
        if constexpr (!Epi::AFTER_DRAIN) { E(acc, cur, wr, wc, fr, fq); S.done(cur); }
        if (!has_next) break;
#pragma unroll
        for (int a = 0; a < 2; ++a)
#pragma unroll
            for (int b = 0; b < 2; ++b)
#pragma unroll
                for (int m = 0; m < 4; ++m)
#pragma unroll
                    for (int n = 0; n < 2; ++n) acc[a][b][m][n] = (f32x4){0.f, 0.f, 0.f, 0.f};
        cur = nxt; cA = nA; cB = nB; ++ui;
        if constexpr (ALIGN_EPI) { if (wr == 1) PG8_BAR; }
    }
    PG8_WAIT_V(0);
    if constexpr (!ALIGN_EPI) { if (wr == 0) PG8_BAR; }
    PG8_BAR;
    if constexpr (Epi::AFTER_DRAIN) { E.fused(acc, cur, wr, wc, fr, fq, lds, wid, lane); S.done(cur); }
#undef PG8_SA
#undef PG8_SB
#undef PG8_STAGE
#undef PG8_LDA
#undef PG8_LDB
#undef PG8_MMA
#undef PG8_WAIT_V
#undef PG8_WAIT_L
#undef PG8_BAR
#undef PG8_SCHED
}
}

constexpr int SEQ = 8192, BATCH = 2, M = BATCH * SEQ, D = 1024, DIN = 2560, FF = 4096, NMEM = 256, MM = BATCH * NMEM;
constexpr float EPS = 1e-6f;
constexpr float LOG2E = 1.4426950408889634f;
constexpr float QSCALE = 0.125f * LOG2E;
constexpr float XQSCALE = 0.0625f * LOG2E;

typedef unsigned short bf16_t;
using pg8::bf16x8; using pg8::f32x4; using pg8::u32x4;
typedef short s16x4 __attribute__((ext_vector_type(4)));
typedef short v4i16_t __attribute__((ext_vector_type(4)));
typedef float f32x2 __attribute__((ext_vector_type(2)));
typedef unsigned u32x2 __attribute__((ext_vector_type(2)));
#define LAS __attribute__((address_space(3)))

constexpr size_t MiB = 1u << 20;
constexpr size_t WS_CS = 1 * MiB, WS_SS1 = 2 * MiB, WS_SS2 = 3 * MiB, WS_SS3 = 4 * MiB, WS_LSE = 5 * MiB, WS_MN = 7 * MiB, WS_XK = 8 * MiB, WS_XV = 9 * MiB;
constexpr size_t WS_WIN = 10 * MiB, WS_WOUT = 15 * MiB, WS_WXQ = 17 * MiB, WS_WXKV = 19 * MiB, WS_WXO = 23 * MiB, WS_WUP = 25 * MiB, WS_WDN = 33 * MiB;
constexpr size_t WS_XN = 42 * MiB, WS_QB = 74 * MiB, WS_KB = 90 * MiB, WS_VB = 106 * MiB, WS_UC = 122 * MiB, WS_MIX = 138 * MiB, WS_OP = 170 * MiB;
constexpr size_t WS_XQ = 74 * MiB, WS_XO = 106 * MiB, WS_U = 74 * MiB, WS_END = 218 * MiB;
constexpr int LDS_BYTES = 163840;
constexpr int NPH = 11;

struct Args { const float* in[19]; float* out; unsigned char* ws; int ph_lo, ph_hi; };

__device__ __forceinline__ unsigned pk2(float lo, float hi) { return pg8::cvt_pk_bf16(lo, hi); }
__device__ __forceinline__ float bflo(unsigned w) { return __uint_as_float(w << 16); }
__device__ __forceinline__ float bfhi(unsigned w) { return __uint_as_float(w & 0xffff0000u); }
__device__ __forceinline__ float wave_sum(float v) {
#pragma unroll
    for (int o = 1; o < 64; o <<= 1) v += __shfl_xor(v, o);
    return v;
}
#define MFMA16(a, b, c) __builtin_amdgcn_mfma_f32_16x16x32_bf16((a), (b), (c), 0, 0, 0)
__device__ __forceinline__ s16x4 vtr(const LAS unsigned char* p) { return __builtin_bit_cast(s16x4, __builtin_amdgcn_ds_read_tr16_b64_v4i16((LAS v4i16_t*)p)); }

struct EpiIn {
    static constexpr bool PERM = true, AFTER_DRAIN = false;
    bf16_t *Qb, *Kb, *Vb, *UC; const float* CS;
    __device__ __forceinline__ void operator()(const f32x4 (&acc)[2][2][4][2], const pg8::Unit& u, int wr, int wc, int fr, int fq) const {
        const int row0 = u.pm * 256 + wr * 64 + fr;
        if (u.pn >= 6) {
            const int ch0 = (u.pn - 6) * 128 + wc * 32 + 8 * fq;
#pragma unroll
            for (int ai = 0; ai < 2; ++ai)
#pragma unroll
                for (int m = 0; m < 4; ++m) {
                    const int row = row0 + ai * 128 + m * 16;
                    float r[8];
#pragma unroll
                    for (int n = 0; n < 2; ++n)
#pragma unroll
                        for (int j = 0; j < 4; ++j) { const float a = acc[ai][0][m][n][j], g = acc[ai][1][m][n][j]; r[4 * n + j] = a * __builtin_amdgcn_rcpf(1.f + __expf(-g)); }
                    u32x4 w; w.x = pk2(r[0], r[1]); w.y = pk2(r[2], r[3]); w.z = pk2(r[4], r[5]); w.w = pk2(r[6], r[7]);
                    *(u32x4*)(UC + (size_t)row * 512 + ch0) = w;
                }
        } else if (u.pn >= 4) {
            const int col0 = (u.pn - 4) * 256 + wc * 32 + 8 * fq;
#pragma unroll
            for (int ai = 0; ai < 2; ++ai)
#pragma unroll
                for (int m = 0; m < 4; ++m) {
                    const int row = row0 + ai * 128 + m * 16;
#pragma unroll
                    for (int bj = 0; bj < 2; ++bj) {
                        const f32x4 v0 = acc[ai][bj][m][0], v1 = acc[ai][bj][m][1];
                        u32x4 w; w.x = pk2(v0[0], v0[1]); w.y = pk2(v0[2], v0[3]); w.z = pk2(v1[0], v1[1]); w.w = pk2(v1[2], v1[3]);
                        *(u32x4*)(Vb + (size_t)row * 512 + col0 + bj * 128) = w;
                    }
                }
        } else {
            bf16_t* dst = (u.pn < 2) ? Qb : Kb; const float sc = (u.pn < 2) ? QSCALE : 1.f;
            const int col0 = (u.pn & 1) * 256 + wc * 32 + 8 * fq;
            const bool rope_wave = (wc & 1) == 0;
            const float sgn = (fq == 0) ? -1.f : 1.f;
#pragma unroll
            for (int ai = 0; ai < 2; ++ai)
#pragma unroll
                for (int m = 0; m < 4; ++m) {
                    const int row = row0 + ai * 128 + m * 16;
                    const int pos = row & (SEQ - 1);
                    f32x4 cs[4];
                    if (rope_wave && fq < 2) {
#pragma unroll
                        for (int q = 0; q < 4; ++q) cs[q] = *(const f32x4*)(CS + (size_t)pos * 16 + 4 * q);
                    }
#pragma unroll
                    for (int bj = 0; bj < 2; ++bj) {
                        float v[8];
#pragma unroll
                        for (int n = 0; n < 2; ++n)
#pragma unroll
                            for (int j = 0; j < 4; ++j) v[4 * n + j] = acc[ai][bj][m][n][j];
                        if (rope_wave) {
#pragma unroll
                            for (int i = 0; i < 8; ++i) {
                                const float p = __shfl_xor(v[i], 16);
                                if (fq < 2) { const float c = cs[i >> 1][2 * (i & 1)], s = cs[i >> 1][2 * (i & 1) + 1]; v[i] = v[i] * c + sgn * p * s; }
                            }
                        }
                        u32x4 w; w.x = pk2(v[0] * sc, v[1] * sc); w.y = pk2(v[2] * sc, v[3] * sc); w.z = pk2(v[4] * sc, v[5] * sc); w.w = pk2(v[6] * sc, v[7] * sc);
                        *(u32x4*)(dst + (size_t)row * 512 + col0 + bj * 128) = w;
                    }
                }
        }
    }
};
struct EpiKV {
    static constexpr bool PERM = true, AFTER_DRAIN = false;
    bf16_t *XK, *XV;
    __device__ __forceinline__ void operator()(const f32x4 (&acc)[2][2][4][2], const pg8::Unit& u, int wr, int wc, int fr, int fq) const {
        const int row0 = u.pm * 256 + wr * 64 + fr;
        bf16_t* dst = (u.pn < 4) ? XK : XV; const int col0 = (u.pn & 3) * 256 + wc * 32 + 8 * fq;
#pragma unroll
        for (int ai = 0; ai < 2; ++ai)
#pragma unroll
            for (int m = 0; m < 4; ++m) {
                const int row = row0 + ai * 128 + m * 16;
#pragma unroll
                for (int bj = 0; bj < 2; ++bj) {
                    const f32x4 v0 = acc[ai][bj][m][0], v1 = acc[ai][bj][m][1];
                    u32x4 w; w.x = pk2(v0[0], v0[1]); w.y = pk2(v0[2], v0[3]); w.z = pk2(v1[0], v1[1]); w.w = pk2(v1[2], v1[3]);
                    *(u32x4*)(dst + (size_t)row * 1024 + col0 + bj * 128) = w;
                }
            }
    }
};
template <bool BASE_BF16, bool OUT_F32, bool OUT_BF16> struct EpiRes {
    static constexpr bool PERM = true, AFTER_DRAIN = false;
    const float* base; const bf16_t* baseb; float* out; bf16_t* xn; float* ss;
    __device__ __forceinline__ void operator()(const f32x4 (&acc)[2][2][4][2], const pg8::Unit& u, int wr, int wc, int fr, int fq) const {
        const int row0 = u.pm * 256 + wr * 64 + fr; const int col0 = u.pn * 256 + wc * 32 + 8 * fq;
#pragma unroll
        for (int ai = 0; ai < 2; ++ai)
#pragma unroll
            for (int m = 0; m < 4; ++m) {
                const int row = row0 + ai * 128 + m * 16;
                float s = 0.f;
#pragma unroll
                for (int bj = 0; bj < 2; ++bj) {
                    const size_t o = (size_t)row * D + col0 + bj * 128;
                    f32x4 b0, b1;
                    if (BASE_BF16) { const u32x4 bw = *(const u32x4*)(baseb + o); b0 = (f32x4){bflo(bw.x), bfhi(bw.x), bflo(bw.y), bfhi(bw.y)}; b1 = (f32x4){bflo(bw.z), bfhi(bw.z), bflo(bw.w), bfhi(bw.w)}; }
                    else { b0 = *(const f32x4*)(base + o); b1 = *(const f32x4*)(base + o + 4); }
                    const f32x4 v0 = acc[ai][bj][m][0] + b0, v1 = acc[ai][bj][m][1] + b1;
                    if (OUT_F32) { *(f32x4*)(out + o) = v0; *(f32x4*)(out + o + 4) = v1; }
                    if (OUT_BF16) { u32x4 w; w.x = pk2(v0[0], v0[1]); w.y = pk2(v0[2], v0[3]); w.z = pk2(v1[0], v1[1]); w.w = pk2(v1[2], v1[3]); *(u32x4*)(xn + o) = w; }
                    s += (v0[0] * v0[0] + v0[1] * v0[1]) + (v0[2] * v0[2] + v0[3] * v0[3]) + (v1[0] * v1[0] + v1[1] * v1[1]) + (v1[2] * v1[2] + v1[3] * v1[3]);
                }
                s += __shfl_xor(s, 16); s += __shfl_xor(s, 32);
                if (fq == 0) ss[(size_t)row * 16 + u.pn * 4 + wc] = s;
            }
    }
};
template <int ACT> struct EpiScale {
    static constexpr bool PERM = true, AFTER_DRAIN = false;
    bf16_t* O; int ldc; const float* ss; float scale;
    __device__ __forceinline__ void operator()(const f32x4 (&acc)[2][2][4][2], const pg8::Unit& u, int wr, int wc, int fr, int fq) const {
        const int row0 = u.pm * 256 + wr * 64 + fr; const int col0 = u.pn * 256 + wc * 32 + 8 * fq;
#pragma unroll
        for (int ai = 0; ai < 2; ++ai)
#pragma unroll
            for (int m = 0; m < 4; ++m) {
                const int row = row0 + ai * 128 + m * 16;
                const f32x4 s0 = *(const f32x4*)(ss + (size_t)row * 16), s1 = *(const f32x4*)(ss + (size_t)row * 16 + 4), s2 = *(const f32x4*)(ss + (size_t)row * 16 + 8), s3 = *(const f32x4*)(ss + (size_t)row * 16 + 12);
                const f32x4 st = (s0 + s1) + (s2 + s3);
                const float rstd = rsqrtf(((st[0] + st[1]) + (st[2] + st[3])) * (1.f / D) + EPS) * scale;
#pragma unroll
                for (int bj = 0; bj < 2; ++bj) {
                    f32x4 v0 = acc[ai][bj][m][0] * rstd, v1 = acc[ai][bj][m][1] * rstd;
                    if (ACT == 1) {
#pragma unroll
                        for (int j = 0; j < 4; ++j) { const float a = fmaxf(v0[j], 0.f), b = fmaxf(v1[j], 0.f); v0[j] = a * a; v1[j] = b * b; }
                    }
                    u32x4 w; w.x = pk2(v0[0], v0[1]); w.y = pk2(v0[2], v0[3]); w.z = pk2(v1[0], v1[1]); w.w = pk2(v1[2], v1[3]);
                    *(u32x4*)(O + (size_t)row * ldc + col0 + bj * 128) = w;
                }
            }
    }
};

__device__ __forceinline__ void p0_transpose_item(const float* __restrict__ W, int K, int N, bf16_t* WT, int dest_row0, const float* __restrict__ gk, LAS float* scr, int k0, int n0, int lane) {
    const float* wp = W + (size_t)(k0 + (lane >> 5)) * N + n0 + (lane & 31);
    float v[32];
#pragma unroll
    for (int i = 0; i < 32; ++i) v[i] = wp[(size_t)(2 * i) * N];
    const int c = lane & 7;
    f32x4 g0 = {1.f, 1.f, 1.f, 1.f}, g1 = {1.f, 1.f, 1.f, 1.f};
    if (gk) { g0 = *(const f32x4*)(gk + k0 + 8 * c); g1 = *(const f32x4*)(gk + k0 + 8 * c + 4); }
#pragma unroll
    for (int i = 0; i < 32; ++i) scr[(2 * i + (lane >> 5)) * 33 + (lane & 31)] = v[i];
    asm volatile("s_waitcnt lgkmcnt(0)" ::: "memory");
#pragma unroll
    for (int j = 0; j < 4; ++j) { const int n = (lane >> 3) + 8 * j; const LAS float* s = scr + (8 * c) * 33 + n;
        u32x4 o; o.x = pk2(s[0 * 33] * g0[0], s[1 * 33] * g0[1]); o.y = pk2(s[2 * 33] * g0[2], s[3 * 33] * g0[3]); o.z = pk2(s[4 * 33] * g1[0], s[5 * 33] * g1[1]); o.w = pk2(s[6 * 33] * g1[2], s[7 * 33] * g1[3]);
        *(u32x4*)(WT + (size_t)(dest_row0 + n) * K + k0 + 8 * c) = o; }
    asm volatile("s_waitcnt lgkmcnt(0)" ::: "memory");
}
__device__ __forceinline__ int win_dest_row(int n0) {
    if (n0 < 1536) return n0;
    const int cc = n0 - 1536, isg = cc >= 512, ch = cc & 511;
    return 1536 + 256 * (ch >> 7) + 128 * isg + (ch & 127);
}
__device__ __forceinline__ void rms_rows_to_bf16(const float* __restrict__ x, const float* __restrict__ g, bf16_t* o, int first, int stride, int nrows, int lane) {
    if (first >= nrows) return;
    f32x4 gg[4], cur[4], nxt[4];
#pragma unroll
    for (int j = 0; j < 4; ++j) { gg[j] = *(const f32x4*)(g + 4 * lane + 256 * j); cur[j] = *(const f32x4*)(x + (size_t)first * D + 4 * lane + 256 * j); nxt[j] = cur[j]; }
#pragma unroll 1
    for (int m = first; m < nrows; m += stride) {
        const int mn = m + stride;
        if (mn < nrows) {
#pragma unroll
            for (int j = 0; j < 4; ++j) nxt[j] = *(const f32x4*)(x + (size_t)mn * D + 4 * lane + 256 * j);
        }
        float s = 0.f;
#pragma unroll
        for (int j = 0; j < 4; ++j) s += (cur[j][0] * cur[j][0] + cur[j][1] * cur[j][1]) + (cur[j][2] * cur[j][2] + cur[j][3] * cur[j][3]);
        const float rstd = rsqrtf(wave_sum(s) * (1.f / D) + EPS);
#pragma unroll
        for (int j = 0; j < 4; ++j) { const f32x4 y = cur[j] * rstd * gg[j];
            u32x2 w; w.x = pk2(y[0], y[1]); w.y = pk2(y[2], y[3]); *(u32x2*)(o + (size_t)m * D + 4 * lane + 256 * j) = w; cur[j] = nxt[j]; }
    }
}
__device__ __forceinline__ void p0_prologue(LAS unsigned char* lds, const Args& a, int tid) {
    const int lane = tid & 63, wave = __builtin_amdgcn_readfirstlane(tid >> 6);
    LAS float* scr = (LAS float*)(lds + wave * 16384);
    const int gw = blockIdx.x * 8 + wave, NGW = gridDim.x * 8;
    unsigned char* ws = a.ws;
    constexpr int I_IN = 16 * 80, I_SQ = 16 * 32;
    constexpr int NITEMS = I_IN + 2 * I_SQ;
    for (int it = gw; it < NITEMS; it += NGW) {
        int r = it;
        if (r < I_IN) { const int kb = r / 80, nb = r % 80; p0_transpose_item(a.in[3], D, DIN, (bf16_t*)(ws + WS_WIN), win_dest_row(32 * nb), nullptr, scr, 64 * kb, 32 * nb, lane); continue; } r -= I_IN;
        if (r < I_SQ) { p0_transpose_item(a.in[12], D, D, (bf16_t*)(ws + WS_WXKV), 32 * (r % 32), nullptr, scr, 64 * (r / 32), 32 * (r % 32), lane); continue; } r -= I_SQ;
        p0_transpose_item(a.in[13], D, D, (bf16_t*)(ws + WS_WXKV), 1024 + 32 * (r % 32), nullptr, scr, 64 * (r / 32), 32 * (r % 32), lane);
    }
    rms_rows_to_bf16(a.in[0], a.in[2], (bf16_t*)(ws + WS_XN), gw, NGW, M, lane);
    rms_rows_to_bf16(a.in[1], a.in[10], (bf16_t*)(ws + WS_MN), gw, NGW, MM, lane);
    float* CS = (float*)(ws + WS_CS);
    for (int idx = blockIdx.x * 512 + tid; idx < SEQ * 8; idx += gridDim.x * 512) {
        const int pos = idx >> 3, i = idx & 7;
        const float freq = powf(500000.0f, -(float)(2 * i) / 16.0f);
        const float ang = (float)pos * freq;
        CS[2 * idx] = cosf(ang); CS[2 * idx + 1] = sinf(ang);
    }
}

__device__ __forceinline__ void late_weights(LAS unsigned char* lds, const Args& a, int tid, int hw, int nh) {
    const int lane = tid & 63, wave = __builtin_amdgcn_readfirstlane(tid >> 6);
    LAS float* scr = (LAS float*)(lds + wave * 16384);
    const int gw = hw * 8 + wave, NGW = nh * 8;
    unsigned char* ws = a.ws;
    constexpr int I_SQ = 16 * 32, I_UP = 16 * 128, I_DN = 64 * 32;
    constexpr int NITEMS = 3 * I_SQ + I_UP + I_DN;
    for (int it = gw; it < NITEMS; it += NGW) {
        int r = it;
        if (r < I_SQ) { p0_transpose_item(a.in[8], D, D, (bf16_t*)(ws + WS_WOUT), 32 * (r % 32), nullptr, scr, 64 * (r / 32), 32 * (r % 32), lane); continue; } r -= I_SQ;
        if (r < I_SQ) { p0_transpose_item(a.in[11], D, D, (bf16_t*)(ws + WS_WXQ), 32 * (r % 32), a.in[9], scr, 64 * (r / 32), 32 * (r % 32), lane); continue; } r -= I_SQ;
        if (r < I_SQ) { p0_transpose_item(a.in[14], D, D, (bf16_t*)(ws + WS_WXO), 32 * (r % 32), nullptr, scr, 64 * (r / 32), 32 * (r % 32), lane); continue; } r -= I_SQ;
        if (r < I_UP) { p0_transpose_item(a.in[16], D, FF, (bf16_t*)(ws + WS_WUP), 32 * (r % 128), a.in[15], scr, 64 * (r / 128), 32 * (r % 128), lane); continue; } r -= I_UP;
        p0_transpose_item(a.in[17], FF, D, (bf16_t*)(ws + WS_WDN), 32 * (r % 32), nullptr, scr, 64 * (r / 32), 32 * (r % 32), lane);
    }
}

constexpr int KV_ROWS = 272, KV_PITCH = 144, KV_BYTES = KV_ROWS * KV_PITCH, KV_IMG = 2 * KV_BYTES + KV_ROWS * 4;
static_assert(2 * KV_IMG <= LDS_BYTES - 64, "two dattn images fit");
constexpr int N_DATTN_UNITS = BATCH * 8 * 192;
struct DUnit { int h, d, L, r, j0, pat; size_t rowbase; };
__device__ __forceinline__ DUnit dattn_decode(int unit) {
    DUnit u; const int bh = unit / 192, rem = unit % 192, blk = rem % 64; u.pat = rem / 64;
    u.h = bh & 7; u.rowbase = (size_t)(bh >> 3) * SEQ;
    const int dsh = 2 * u.pat; u.d = 1 << dsh; u.L = SEQ >> dsh; const int nblk = u.L >> 7;
    u.r = blk / nblk; u.j0 = (blk % nblk) * 128; return u;
}
__device__ __forceinline__ int dattn_row(int i, int tid) { return (tid >> 3) + (i < 4 ? 64 * i : (i == 4 ? (tid < 128 ? 256 : -16) : 64 * (i - 5) + 48)); }
__device__ __forceinline__ void dattn_issue(const DUnit& u, const bf16_t* __restrict__ Qb, const bf16_t* __restrict__ Kb, const bf16_t* __restrict__ Vb, u32x4 (&kv)[9], bf16x8& qf0, bf16x8& qf1, int tid, int w, int ql, int g) {
    const unsigned stride = (unsigned)u.d * 1024u;
    const char* kbase = (const char*)(Kb + (u.rowbase + u.r) * 512 + u.h * 64);
    const char* vbase = (const char*)(Vb + (u.rowbase + u.r) * 512 + u.h * 64);
    const unsigned chb = (unsigned)(tid & 7) * 16u;
#pragma unroll
    for (int i = 0; i < 9; ++i) {
        int j = u.j0 - 64 + dattn_row(i, tid); j = j < 0 ? 0 : (j > u.L - 1 ? u.L - 1 : j);
        const unsigned off = (unsigned)j * stride + chb;
        const char* base = (i < 4) ? kbase : ((i > 4) ? vbase : (tid < 128 ? kbase : vbase));
        if (i < 8 || tid < 256) kv[i] = *(const u32x4*)(base + off);
    }
    const size_t qrow = u.rowbase + (size_t)(u.j0 + 16 * w + ql) * u.d + u.r;
    const bf16_t* qp = Qb + qrow * 512 + u.h * 64 + 8 * g;
    qf0 = *(const bf16x8*)qp; qf1 = *(const bf16x8*)(qp + 32);
}
struct DOut { u32x2 v[4]; float lse; bf16_t* op; float* lp; };
__device__ __forceinline__ void dattn_store(const DOut& o, int g) {
#pragma unroll
    for (int dt = 0; dt < 4; ++dt) *(u32x2*)(o.op + 16 * dt) = o.v[dt];
    if (g == 0) *o.lp = o.lse;
}
__device__ __forceinline__ void dattn_compute(LAS unsigned char* img, const DUnit& u, const bf16x8 qf0, const bf16x8 qf1, bf16_t* OP, float* LSE, int w, int ql, int g, DOut& out) {
    const int jq = u.j0 + 16 * w + ql; const size_t qrow = u.rowbase + (size_t)jq * u.d + u.r;
    f32x4 st[9];
    const LAS unsigned char* kp = img + (16 * w + ql) * KV_PITCH + g * 16;
    const LAS unsigned char* bp = img + 2 * KV_BYTES + (16 * w + 4 * g) * 4;
    const int dbase = 4 * g - 64 - ql;
#pragma unroll
    for (int t = 0; t < 9; ++t) {
        const bf16x8 k0 = *(const LAS bf16x8*)(kp + t * 16 * KV_PITCH), k1 = *(const LAS bf16x8*)(kp + t * 16 * KV_PITCH + 64);
        f32x4 z = *(const LAS f32x4*)(bp + t * 64);
        if (t == 0) {
#pragma unroll
            for (int i = 0; i < 4; ++i) z[i] = (dbase + i >= -64) ? z[i] : -1e30f;
        }
        if (t == 8) {
#pragma unroll
            for (int i = 0; i < 4; ++i) z[i] = (dbase + 128 + i <= 64) ? z[i] : -1e30f;
        }
        z = MFMA16(k0, qf0, z); st[t] = MFMA16(k1, qf1, z);
    }
    float mx = -1e30f;
#pragma unroll
    for (int t = 0; t < 9; ++t) mx = fmaxf(mx, fmaxf(fmaxf(st[t][0], st[t][1]), fmaxf(st[t][2], st[t][3])));
    mx = fmaxf(mx, __shfl_xor(mx, 16)); mx = fmaxf(mx, __shfl_xor(mx, 32));
    float lsum = 0.f;
#pragma unroll
    for (int t = 0; t < 9; ++t)
#pragma unroll
        for (int i = 0; i < 4; ++i) { const float p = __builtin_amdgcn_exp2f(st[t][i] - mx); st[t][i] = p; lsum += p; }
    lsum += __shfl_xor(lsum, 16); lsum += __shfl_xor(lsum, 32);
    bf16x8 pf[5];
#pragma unroll
    for (int s = 0; s < 5; ++s) {
        u32x4 wv; wv.x = pk2(st[2 * s][0], st[2 * s][1]); wv.y = pk2(st[2 * s][2], st[2 * s][3]);
        if (2 * s + 1 < 9) { wv.z = pk2(st[(2 * s + 1) % 9][0], st[(2 * s + 1) % 9][1]); wv.w = pk2(st[(2 * s + 1) % 9][2], st[(2 * s + 1) % 9][3]); } else { wv.z = 0u; wv.w = 0u; }
        pf[s] = __builtin_bit_cast(bf16x8, wv);
    }
    f32x4 o[4];
#pragma unroll
    for (int dt = 0; dt < 4; ++dt) o[dt] = (f32x4){0.f, 0.f, 0.f, 0.f};
    const LAS unsigned char* vp = img + KV_BYTES + (16 * w + 4 * g + (ql >> 2)) * KV_PITCH + (ql & 3) * 8;
#pragma unroll
    for (int s = 0; s < 5; ++s)
#pragma unroll
        for (int dt = 0; dt < 4; ++dt) {
            const s16x4 lo = vtr(vp + (32 * s) * KV_PITCH + dt * 32), hi = vtr(vp + (32 * s + 16) * KV_PITCH + dt * 32);
            const bf16x8 vf = {lo[0], lo[1], lo[2], lo[3], hi[0], hi[1], hi[2], hi[3]};
            o[dt] = MFMA16(vf, pf[s], o[dt]);
        }
    const float inv = __builtin_amdgcn_rcpf(lsum);
    out.op = OP + (size_t)u.pat * M * 512 + qrow * 512 + u.h * 64 + 4 * g;
#pragma unroll
    for (int dt = 0; dt < 4; ++dt) { u32x2 wv; wv.x = pk2(o[dt][0] * inv, o[dt][1] * inv); wv.y = pk2(o[dt][2] * inv, o[dt][3] * inv); out.v[dt] = wv; }
    out.lp = LSE + (size_t)u.pat * M * 8 + qrow * 8 + u.h; out.lse = mx + __builtin_amdgcn_logf(lsum);
}
__device__ __forceinline__ void dattn_phase(LAS unsigned char* lds, const bf16_t* __restrict__ Qb, const bf16_t* __restrict__ Kb, const bf16_t* __restrict__ Vb, bf16_t* OP, float* LSE, int c0, int G, int tid) {
    const int lane = tid & 63, w = __builtin_amdgcn_readfirstlane(tid >> 6), ql = lane & 15, g = lane >> 4;
    int un = c0; if (un >= N_DATTN_UNITS) return;
    u32x4 kv[9]; bf16x8 qn0, qn1;
    DUnit cur = dattn_decode(un);
    dattn_issue(cur, Qb, Kb, Vb, kv, qn0, qn1, tid, w, ql, g);
    int buf = 0; bool pend = false; DOut po;
    const int wbase = (tid >> 3) * KV_PITCH + (tid & 7) * 16;
#pragma unroll 1
    for (;;) {
        LAS unsigned char* img = lds + buf * KV_IMG;
        LAS unsigned char* wk = img + wbase; LAS unsigned char* wv = img + KV_BYTES + wbase;
#pragma unroll
        for (int i = 0; i < 9; ++i) {
            if (i < 4) *(LAS u32x4*)(wk + 64 * i * KV_PITCH) = kv[i];
            else if (i == 4) { if (tid < 128) *(LAS u32x4*)(wk + 256 * KV_PITCH) = kv[i]; else *(LAS u32x4*)(wv - 16 * KV_PITCH) = kv[i]; }
            else if (i < 8 || tid < 256) *(LAS u32x4*)(wv + (64 * (i - 5) + 48) * KV_PITCH) = kv[i];
        }
        if (tid < KV_ROWS) { const int j = cur.j0 - 64 + tid; *(LAS float*)(img + 2 * KV_BYTES + tid * 4) = (j >= 0 && j < cur.L) ? 0.f : -1e30f; }
        const bf16x8 q0 = qn0, q1 = qn1;
        __syncthreads();
        if (pend) dattn_store(po, g);
        un += G; const bool has = un < N_DATTN_UNITS;
        DUnit nxt = cur;
        if (has) { nxt = dattn_decode(un); dattn_issue(nxt, Qb, Kb, Vb, kv, qn0, qn1, tid, w, ql, g); }
        dattn_compute(img, cur, q0, q1, OP, LSE, w, ql, g, po); pend = true;
        if (!has) break;
        cur = nxt; buf ^= 1;
    }
    dattn_store(po, g);
    __syncthreads();
}

constexpr int N_CONV_UNITS = M / 32;
__device__ __forceinline__ void conv_unit(LAS unsigned char* lds, const bf16_t* __restrict__ UC, const float* __restrict__ cw, const float* __restrict__ cb, const float* __restrict__ lg, const float* __restrict__ lb, bf16_t* MIX, int unit, int tid) {
    const int p0 = unit * 32, b = p0 >> 13, t0 = p0 & (SEQ - 1);
    LAS unsigned char* ut = lds; LAS float* ot = (LAS float*)(lds + 63488);
    {
        u32x4 tmp[8];
#pragma unroll
        for (int i = 0; i < 8; ++i) { const int c = tid + 512 * i; const int row = c >> 6, ch = c & 63, t = t0 - 15 + row;
            u32x4 v = {0u, 0u, 0u, 0u};
            if (c < 62 * 64 && t >= 0 && t < SEQ) v = *(const u32x4*)(UC + ((size_t)b * SEQ + t) * 512 + ch * 8);
            tmp[i] = v; }
#pragma unroll
        for (int i = 0; i < 8; ++i) { const int c = tid + 512 * i; const int row = c >> 6, ch = c & 63; if (c < 62 * 64) *(LAS u32x4*)(ut + row * 1024 + ch * 16) = tmp[i]; }
    }
    const int cp = tid & 255, half = tid >> 8;
    f32x2 wk[31];
#pragma unroll
    for (int k = 0; k < 31; ++k) wk[k] = *(const f32x2*)(cw + k * 512 + 2 * cp);
    const f32x2 bias = *(const f32x2*)(cb + 2 * cp);
    __syncthreads();
#pragma unroll 1
    for (int grp = 0; grp < 2; ++grp) {
        const int base = half * 16 + grp * 8;
        f32x2 acc[8];
#pragma unroll
        for (int o = 0; o < 8; ++o) acc[o] = bias;
#pragma unroll
        for (int i = 0; i < 38; ++i) {
            const unsigned xw = *(const LAS unsigned*)(ut + (base + i) * 1024 + cp * 4);
            const f32x2 x = {bflo(xw), bfhi(xw)};
#pragma unroll
            for (int o = 0; o < 8; ++o) { const int k = i - o; if (k >= 0 && k <= 30) acc[o] += wk[k < 0 ? 0 : (k > 30 ? 30 : k)] * x; }
        }
#pragma unroll
        for (int o = 0; o < 8; ++o) *(LAS f32x2*)(ot + (base + o) * 512 + 2 * cp) = acc[o];
    }
    __syncthreads();
    const int lane = tid & 63, w = tid >> 6;
    const f32x4 g0 = *(const f32x4*)(lg + 8 * lane), g1 = *(const f32x4*)(lg + 8 * lane + 4), b0 = *(const f32x4*)(lb + 8 * lane), b1 = *(const f32x4*)(lb + 8 * lane + 4);
#pragma unroll
    for (int pp = 0; pp < 4; ++pp) {
        const int pos = 4 * w + pp;
        const f32x4 x0 = *(const LAS f32x4*)(ot + pos * 512 + 8 * lane), x1 = *(const LAS f32x4*)(ot + pos * 512 + 8 * lane + 4);
        float s = (x0[0] + x0[1]) + (x0[2] + x0[3]) + (x1[0] + x1[1]) + (x1[2] + x1[3]);
        float s2 = (x0[0] * x0[0] + x0[1] * x0[1]) + (x0[2] * x0[2] + x0[3] * x0[3]) + (x1[0] * x1[0] + x1[1] * x1[1]) + (x1[2] * x1[2] + x1[3] * x1[3]);
        s = wave_sum(s); s2 = wave_sum(s2);
        const float mean = s * (1.f / 512.f), var = fmaxf(s2 * (1.f / 512.f) - mean * mean, 0.f), rstd = rsqrtf(var + EPS);
        float y[8];
#pragma unroll
        for (int j = 0; j < 4; ++j) { y[j] = (x0[j] - mean) * rstd * g0[j] + b0[j]; y[4 + j] = (x1[j] - mean) * rstd * g1[j] + b1[j]; }
#pragma unroll
        for (int j = 0; j < 8; ++j) y[j] = y[j] * __builtin_amdgcn_rcpf(1.f + __expf(-y[j]));
        u32x4 wv; wv.x = pk2(y[0], y[1]); wv.y = pk2(y[2], y[3]); wv.z = pk2(y[4], y[5]); wv.w = pk2(y[6], y[7]);
        *(u32x4*)(MIX + (size_t)(p0 + pos) * 1024 + 512 + 8 * lane) = wv;
    }
    __syncthreads();
}

__device__ __forceinline__ void merge_phase(const bf16_t* __restrict__ OP, const float* __restrict__ LSE, bf16_t* MIX, int tid) {
    for (int idx = blockIdx.x * 512 + tid; idx < M * 64; idx += gridDim.x * 512) {
        const int row = idx >> 6, hc = idx & 63, h = hc >> 3;
        const float l0 = LSE[(size_t)row * 8 + h], l1 = LSE[(size_t)M * 8 + (size_t)row * 8 + h], l2 = LSE[(size_t)2 * M * 8 + (size_t)row * 8 + h];
        const float mx = fmaxf(l0, fmaxf(l1, l2));
        float w0 = exp2f(l0 - mx), w1 = exp2f(l1 - mx), w2 = exp2f(l2 - mx);
        const float inv = 1.f / (w0 + w1 + w2); w0 *= inv; w1 *= inv; w2 *= inv;
        const u32x4 a0 = *(const u32x4*)(OP + (size_t)row * 512 + hc * 8), a1 = *(const u32x4*)(OP + (size_t)M * 512 + (size_t)row * 512 + hc * 8), a2 = *(const u32x4*)(OP + (size_t)2 * M * 512 + (size_t)row * 512 + hc * 8);
        u32x4 wv;
#pragma unroll
        for (int q = 0; q < 4; ++q) {
            const float lo = w0 * bflo(a0[q]) + w1 * bflo(a1[q]) + w2 * bflo(a2[q]);
            const float hi = w0 * bfhi(a0[q]) + w1 * bfhi(a1[q]) + w2 * bfhi(a2[q]);
            wv[q] = pk2(lo, hi);
        }
        *(u32x4*)(MIX + (size_t)row * 1024 + hc * 8) = wv;
    }
}

constexpr int XP = 528, XPV = 544;
constexpr int N_XATTN_UNITS = BATCH * 4 * (SEQ / 256);
__device__ __forceinline__ void xattn_unit(LAS unsigned char* lds, const bf16_t* __restrict__ XQ, const bf16_t* __restrict__ XK, const bf16_t* __restrict__ XV, bf16_t* XO, int unit, int tid) {
    const int lane = tid & 63, w = __builtin_amdgcn_readfirstlane(tid >> 6), ql = lane & 15, g = lane >> 4;
    const int b = unit >> 7, xh = (unit >> 5) & 3, qb = unit & 31;
#pragma unroll 1
    for (int hb = 0; hb < 2; ++hb) {
        u32x4 tmp[8];
#pragma unroll
        for (int i = 0; i < 8; ++i) { const int c = tid + 512 * (8 * hb + i); const int row = c >> 5, ch = c & 31; tmp[i] = *(const u32x4*)(XK + (size_t)(b * NMEM + row) * 1024 + xh * 256 + ch * 8); }
#pragma unroll
        for (int i = 0; i < 8; ++i) { const int c = tid + 512 * (8 * hb + i); const int row = c >> 5, ch = c & 31; *(LAS u32x4*)(lds + row * XP + ch * 16) = tmp[i]; }
    }
    const size_t qrow0 = (size_t)b * SEQ + qb * 256 + 32 * w + ql;
    bf16x8 qf[2][8];
#pragma unroll
    for (int qt = 0; qt < 2; ++qt)
#pragma unroll
        for (int ks = 0; ks < 8; ++ks) qf[qt][ks] = *(const bf16x8*)(XQ + (qrow0 + 16 * qt) * 1024 + xh * 256 + 32 * ks + 8 * g);
    __syncthreads();
    f32x4 st[16][2];
    const LAS unsigned char* kp = lds + ql * XP + g * 16;
#pragma unroll
    for (int t = 0; t < 16; ++t) {
        f32x4 z0 = {0.f, 0.f, 0.f, 0.f}, z1 = {0.f, 0.f, 0.f, 0.f};
#pragma unroll
        for (int ks = 0; ks < 8; ++ks) { const bf16x8 kf = *(const LAS bf16x8*)(kp + t * 16 * XP + ks * 64); z0 = MFMA16(kf, qf[0][ks], z0); z1 = MFMA16(kf, qf[1][ks], z1); }
        st[t][0] = z0; st[t][1] = z1;
    }
    float inv[2];
    bf16x8 pf[2][8];
#pragma unroll
    for (int qt = 0; qt < 2; ++qt) {
        float mx = -1e30f;
#pragma unroll
        for (int t = 0; t < 16; ++t)
#pragma unroll
            for (int i = 0; i < 4; ++i) mx = fmaxf(mx, st[t][qt][i]);
        mx = fmaxf(mx, __shfl_xor(mx, 16)); mx = fmaxf(mx, __shfl_xor(mx, 32));
        float lsum = 0.f;
#pragma unroll
        for (int t = 0; t < 16; ++t)
#pragma unroll
            for (int i = 0; i < 4; ++i) { const float p = __builtin_amdgcn_exp2f(st[t][qt][i] - mx); st[t][qt][i] = p; lsum += p; }
        lsum += __shfl_xor(lsum, 16); lsum += __shfl_xor(lsum, 32);
        inv[qt] = __builtin_amdgcn_rcpf(lsum);
#pragma unroll
        for (int s = 0; s < 8; ++s) {
            u32x4 wv; wv.x = pk2(st[2 * s][qt][0], st[2 * s][qt][1]); wv.y = pk2(st[2 * s][qt][2], st[2 * s][qt][3]);
            wv.z = pk2(st[2 * s + 1][qt][0], st[2 * s + 1][qt][1]); wv.w = pk2(st[2 * s + 1][qt][2], st[2 * s + 1][qt][3]);
            pf[qt][s] = __builtin_bit_cast(bf16x8, wv);
        }
    }
    __syncthreads();
#pragma unroll 1
    for (int hb = 0; hb < 2; ++hb) {
        u32x4 tmp[8];
#pragma unroll
        for (int i = 0; i < 8; ++i) { const int c = tid + 512 * (8 * hb + i); const int row = c >> 5, ch = c & 31; tmp[i] = *(const u32x4*)(XV + (size_t)(b * NMEM + row) * 1024 + xh * 256 + ch * 8); }
#pragma unroll
        for (int i = 0; i < 8; ++i) { const int c = tid + 512 * (8 * hb + i); const int row = c >> 5, ch = c & 31; *(LAS u32x4*)(lds + row * XPV + ch * 16) = tmp[i]; }
    }
    __syncthreads();
    const LAS unsigned char* vp = lds + (4 * g + (ql >> 2)) * XPV + (ql & 3) * 8;
#pragma unroll
    for (int hf = 0; hf < 2; ++hf) {
        f32x4 o[8][2];
#pragma unroll
        for (int dd = 0; dd < 8; ++dd) { o[dd][0] = (f32x4){0.f, 0.f, 0.f, 0.f}; o[dd][1] = (f32x4){0.f, 0.f, 0.f, 0.f}; }
#pragma unroll
        for (int s = 0; s < 8; ++s)
#pragma unroll
            for (int dd = 0; dd < 8; ++dd) {
                const int dt = hf * 8 + dd;
                const s16x4 lo = vtr(vp + (32 * s) * XPV + dt * 32), hi = vtr(vp + (32 * s + 16) * XPV + dt * 32);
                const bf16x8 vf = {lo[0], lo[1], lo[2], lo[3], hi[0], hi[1], hi[2], hi[3]};
                o[dd][0] = MFMA16(vf, pf[0][s], o[dd][0]); o[dd][1] = MFMA16(vf, pf[1][s], o[dd][1]);
            }
#pragma unroll
        for (int qt = 0; qt < 2; ++qt)
#pragma unroll
            for (int dd = 0; dd < 8; ++dd) {
                u32x2 wv; wv.x = pk2(o[dd][qt][0] * inv[qt], o[dd][qt][1] * inv[qt]); wv.y = pk2(o[dd][qt][2] * inv[qt], o[dd][qt][3] * inv[qt]);
                *(u32x2*)(XO + (qrow0 + 16 * qt) * 1024 + xh * 256 + 16 * (hf * 8 + dd) + 4 * g) = wv;
            }
    }
    __syncthreads();
}

__device__ __forceinline__ void final_phase(float* out, const bf16_t* __restrict__ hb, const float* __restrict__ ss, const float* __restrict__ gfin, int tid) {
    const int lane = tid & 63, wave = tid >> 6;
    for (int row = blockIdx.x * 8 + wave; row < M; row += gridDim.x * 8) {
        float s = ss[(size_t)row * 16 + (lane & 15)];
        s += __shfl_xor(s, 1); s += __shfl_xor(s, 2); s += __shfl_xor(s, 4); s += __shfl_xor(s, 8);
        const float rstd = rsqrtf(s * (1.f / D) + EPS);
#pragma unroll
        for (int j = 0; j < 2; ++j) {
            const int col = 8 * lane + 512 * j;
            const u32x4 w = *(const u32x4*)(hb + (size_t)row * D + col);
            const f32x4 g0 = *(const f32x4*)(gfin + col), g1 = *(const f32x4*)(gfin + col + 4);
            const f32x4 v0 = {bflo(w.x), bfhi(w.x), bflo(w.y), bfhi(w.y)}, v1 = {bflo(w.z), bfhi(w.z), bflo(w.w), bfhi(w.w)};
            *(f32x4*)(out + (size_t)row * D + col) = v0 * rstd * g0; *(f32x4*)(out + (size_t)row * D + col + 4) = v1 * rstd * g1;
        }
    }
}

#define XB_TMO      128
#define XB_XCNT(j)  (256  + 64 * (j))
#define XB_XSUB(j)  (1280 + 64 * (j))
#define XB_XGEN(j)  (2304 + 64 * (j))
#define XB_TOP      3328
#define XB_TOPGEN   3392
#define XCD_BAR_WORDS 3456
#define XB_SPIN_CAP (1u << 18)

__device__ __forceinline__ unsigned xb_ld(unsigned* p)              { return __hip_atomic_load(p, __ATOMIC_RELAXED, __HIP_MEMORY_SCOPE_AGENT); }
__device__ __forceinline__ unsigned xb_add(unsigned* p, unsigned v) { return __hip_atomic_fetch_add(p, v, __ATOMIC_RELAXED, __HIP_MEMORY_SCOPE_AGENT); }
__device__ __forceinline__ unsigned xb_xcc_id() { return (unsigned)__builtin_amdgcn_s_getreg((3 << 11) | 20) & 0xFu; }
#define XB_SPIN(cond, bar) do { unsigned _sp = 0; while (cond) { __builtin_amdgcn_s_sleep(1); \
    if ((++_sp & 255u) == 0u) { if (xb_ld(&(bar)[XB_TMO])) break; if (_sp > XB_SPIN_CAP) { atomicAdd(&(bar)[XB_TMO], 1u); break; } } } } while (0)

struct XcdBarrier {
    unsigned* bar; unsigned x;
    volatile LAS unsigned* st;
};

__device__ __forceinline__ XcdBarrier xcd_barrier_post(unsigned* bar, volatile LAS unsigned* st) {
    XcdBarrier b; b.bar = bar; b.x = xb_xcc_id(); b.st = st;
    if (threadIdx.x == 0) (void)xb_add(&bar[XB_XCNT(b.x)], 1u);
    return b;
}
__device__ __forceinline__ void xcd_barrier_complete(unsigned* bar, unsigned x, unsigned& nloc, unsigned& nx) {
    const unsigned G = gridDim.x * gridDim.y * gridDim.z;
    unsigned sum, cnt, mine, sp = 0u;
    for (;;) {
        sum = 0u; cnt = 0u; mine = 0u;
#pragma unroll
        for (unsigned j = 0; j < 16; ++j) { const unsigned c = xb_ld(&bar[XB_XCNT(j)]); sum += c; cnt += (c > 0u) ? 1u : 0u; mine = (j == x) ? c : mine; }
        if (sum == G) break;
        __builtin_amdgcn_s_sleep(1);
        if ((++sp & 255u) == 0u) { if (xb_ld(&bar[XB_TMO])) break; if (sp > XB_SPIN_CAP) { atomicAdd(&bar[XB_TMO], 1u); break; } }
    }
    nloc = mine > 0u ? mine : 1u; nx = cnt > 0u ? cnt : 1u;
}

__device__ __forceinline__ void xcd_barrier(const XcdBarrier& b) {
    asm volatile("s_waitcnt vmcnt(0)" ::: "memory");
    __syncthreads();
    if (threadIdx.x == 0) {
        unsigned* bar = b.bar;
        __builtin_amdgcn_s_waitcnt(0);
        unsigned nloc = b.st[0], nx = b.st[1];
        if (nloc == 0u) { xcd_barrier_complete(bar, b.x, nloc, nx); b.st[0] = nloc; b.st[1] = nx; }
        const unsigned old = xb_add(&bar[XB_XSUB(b.x)], 1u);
        const unsigned gen = old / nloc;
        if (old + 1u == (gen + 1u) * nloc) {
            __builtin_amdgcn_fence(__ATOMIC_RELEASE, "agent");
            asm volatile("s_waitcnt vmcnt(0)" ::: "memory");
            const unsigned og = xb_add(&bar[XB_TOP], 1u);
            const unsigned tg = og / nx;
            if (og + 1u == (tg + 1u) * nx) xb_add(&bar[XB_TOPGEN], 1u);
            else XB_SPIN(xb_ld(&bar[XB_TOPGEN]) == tg, bar);
            __builtin_amdgcn_fence(__ATOMIC_ACQUIRE, "agent");
            xb_add(&bar[XB_XGEN(b.x)], 1u);
            asm volatile("s_waitcnt vmcnt(0)" ::: "memory");
        } else {
            XB_SPIN(xb_ld(&bar[XB_XGEN(b.x)]) == gen, bar);
            __builtin_amdgcn_fence(__ATOMIC_ACQUIRE, "agent");
            asm volatile("s_waitcnt vmcnt(0)" ::: "memory");
        }
    }
    __syncthreads();
}


__global__ void __launch_bounds__(512, 2) fwd_megakernel(Args a) {
    extern __shared__ __attribute__((aligned(16))) unsigned char lds_raw[];
    LAS unsigned char* lds = (LAS unsigned char*)lds_raw;
    const int tid = threadIdx.x;
    unsigned char* ws = a.ws;
    const int lo = a.ph_lo, hi = a.ph_hi;
    const int G = gridDim.x, c = blockIdx.x;
    const int vc = (G % 8 == 0) ? (c % 8) * (G / 8) + c / 8 : c;
    bf16_t* XN = (bf16_t*)(ws + WS_XN);
    volatile LAS unsigned* bst = (volatile LAS unsigned*)(lds + LDS_BYTES - 64);
    if (tid == 0) { bst[0] = 0u; bst[1] = 0u; }
    __syncthreads();
    XcdBarrier bar = xcd_barrier_post((unsigned*)ws, bst);
    if (a.ph_hi < 0) cg::this_grid().sync();
#define IN(k) (lo <= (k) && (k) < hi)
#ifndef PROBE_PH
#define PROBE_PH (-1)
#endif
#if PROBE_PH >= 0
    unsigned long long tA = 0, tB = 0;
#define STAMP(k) do { if ((k) == PROBE_PH - 1) tA = __builtin_amdgcn_s_memrealtime(); if ((k) == PROBE_PH) tB = __builtin_amdgcn_s_memrealtime(); } while (0)
#else
#define STAMP(k) do { } while (0)
#endif
#define SEAM(k) do { if (IN(k) && IN((k) + 1)) xcd_barrier(bar); STAMP(k); } while (0)
    STAMP(-1);

#ifndef PROBE_P0
#define PROBE_P0 0
#define PROBE_P2 0
#define PROBE_P6 0
#define PROBE_SYNC 0
#define PROBE_P3 0
#endif
    if (IN(0)) p0_prologue(lds, a, tid);
#if PROBE_P0
    if (IN(0)) p0_prologue(lds, a, tid);
#endif
    #if PROBE_SYNC
    _Pragma("unroll 1") for (int rep = 0; rep < PROBE_SYNC; ++rep) xcd_barrier(bar);
#endif
    SEAM(0);
    if (IN(1)) {
        { pg8::Gemm g{XN, (const bf16_t*)(ws + WS_WIN), M, DIN, D}; pg8::StaticOrder S; S.init(M, DIN, G, c);
          EpiIn E{(bf16_t*)(ws + WS_QB), (bf16_t*)(ws + WS_KB), (bf16_t*)(ws + WS_VB), (bf16_t*)(ws + WS_UC), (const float*)(ws + WS_CS)};
          pg8::gemm_phase<EpiIn, pg8::StaticOrder, true, true>(lds, g, S, E); }
        { const int c2 = (c + G - (640 % G)) % G;
          pg8::Gemm g{(const bf16_t*)(ws + WS_MN), (const bf16_t*)(ws + WS_WXKV), MM, 2048, D}; pg8::StaticOrder S; S.init(MM, 2048, G, c2);
          EpiKV E{(bf16_t*)(ws + WS_XK), (bf16_t*)(ws + WS_XV)};
          pg8::gemm_phase<EpiKV, pg8::StaticOrder, true, true>(lds, g, S, E);
          const int nidle = (G == 256) ? 112 : G; const int hw = (G == 256) ? c2 - 16 : c;
          if (hw >= 0 && hw < nidle) { __syncthreads(); late_weights(lds, a, tid, hw, nidle); } }
    }
    SEAM(1);
    if (IN(2)) {
        dattn_phase(lds, (const bf16_t*)(ws + WS_QB), (const bf16_t*)(ws + WS_KB), (const bf16_t*)(ws + WS_VB), (bf16_t*)(ws + WS_OP), (float*)(ws + WS_LSE), vc, G, tid);
        for (int u = vc; u < N_CONV_UNITS; u += G) conv_unit(lds, (const bf16_t*)(ws + WS_UC), a.in[4], a.in[5], a.in[6], a.in[7], (bf16_t*)(ws + WS_MIX), u, tid);
    }
    #if PROBE_P2
    __syncthreads();
if (IN(2)) {
        dattn_phase(lds, (const bf16_t*)(ws + WS_QB), (const bf16_t*)(ws + WS_KB), (const bf16_t*)(ws + WS_VB), (bf16_t*)(ws + WS_OP), (float*)(ws + WS_LSE), vc, G, tid);
        for (int u = vc; u < N_CONV_UNITS; u += G) conv_unit(lds, (const bf16_t*)(ws + WS_UC), a.in[4], a.in[5], a.in[6], a.in[7], (bf16_t*)(ws + WS_MIX), u, tid);
    }
    #endif
    SEAM(2);
    if (IN(3)) merge_phase((const bf16_t*)(ws + WS_OP), (const float*)(ws + WS_LSE), (bf16_t*)(ws + WS_MIX), tid);
    #if PROBE_P3
if (IN(3)) merge_phase((const bf16_t*)(ws + WS_OP), (const float*)(ws + WS_LSE), (bf16_t*)(ws + WS_MIX), tid);
    #endif
    SEAM(3);
    if (IN(4)) { pg8::Gemm g{(const bf16_t*)(ws + WS_MIX), (const bf16_t*)(ws + WS_WOUT), M, D, D}; pg8::StaticOrder S; S.init(M, D, G, c);
        EpiRes<false, false, true> E{a.in[0], nullptr, nullptr, XN, (float*)(ws + WS_SS1)};
        pg8::gemm_phase<EpiRes<false, false, true>, pg8::StaticOrder, true, true>(lds, g, S, E); }
    SEAM(4);
    if (IN(5)) { pg8::Gemm g{XN, (const bf16_t*)(ws + WS_WXQ), M, D, D}; pg8::StaticOrder S; S.init(M, D, G, c);
        EpiScale<0> E{(bf16_t*)(ws + WS_XQ), D, (const float*)(ws + WS_SS1), XQSCALE};
        pg8::gemm_phase<EpiScale<0>, pg8::StaticOrder, true, true>(lds, g, S, E); }
    SEAM(5);
    if (IN(6)) { for (int u = vc; u < N_XATTN_UNITS; u += G) xattn_unit(lds, (const bf16_t*)(ws + WS_XQ), (const bf16_t*)(ws + WS_XK), (const bf16_t*)(ws + WS_XV), (bf16_t*)(ws + WS_XO), u, tid); }
    #if PROBE_P6
if (IN(6)) { for (int u = vc; u < N_XATTN_UNITS; u += G) xattn_unit(lds, (const bf16_t*)(ws + WS_XQ), (const bf16_t*)(ws + WS_XK), (const bf16_t*)(ws + WS_XV), (bf16_t*)(ws + WS_XO), u, tid); }
    #endif
    SEAM(6);
    if (IN(7)) { pg8::Gemm g{(const bf16_t*)(ws + WS_XO), (const bf16_t*)(ws + WS_WXO), M, D, D}; pg8::StaticOrder S; S.init(M, D, G, c);
        EpiRes<true, false, true> E{nullptr, XN, nullptr, XN, (float*)(ws + WS_SS2)};
        pg8::gemm_phase<EpiRes<true, false, true>, pg8::StaticOrder, true, true>(lds, g, S, E); }
    SEAM(7);
    if (IN(8)) { pg8::Gemm g{XN, (const bf16_t*)(ws + WS_WUP), M, FF, D}; pg8::StaticOrder S; S.init(M, FF, G, c);
        EpiScale<1> E{(bf16_t*)(ws + WS_U), FF, (const float*)(ws + WS_SS2), 1.f};
        pg8::gemm_phase<EpiScale<1>, pg8::StaticOrder, true, true>(lds, g, S, E); }
    SEAM(8);
    if (IN(9)) { pg8::Gemm g{(const bf16_t*)(ws + WS_U), (const bf16_t*)(ws + WS_WDN), M, D, FF}; pg8::StaticOrder S; S.init(M, D, G, c);
        EpiRes<true, false, true> E{nullptr, XN, nullptr, XN, (float*)(ws + WS_SS3)};
        pg8::gemm_phase<EpiRes<true, false, true>, pg8::StaticOrder, true, true>(lds, g, S, E); }
    SEAM(9);
    if (IN(10)) final_phase(a.out, XN, (const float*)(ws + WS_SS3), a.in[18], tid);
    STAMP(10);
#if PROBE_PH >= 0
    if (c == 0 && tid == 0) { const unsigned long long dly = (tB - tA) * 4ull, t0 = __builtin_amdgcn_s_memrealtime(); while (__builtin_amdgcn_s_memrealtime() - t0 < dly) __builtin_amdgcn_s_sleep(20); }
#endif
#undef IN
#undef SEAM
}

#ifndef MK_SPLIT
#define MK_SPLIT 0
#endif
extern "C" void kernel_launch(void* const* d_in, const int* in_sizes, int n_in, void* d_out, int out_size, void* d_ws, size_t ws_size, hipStream_t stream) {
    static int grid = 0;
    if (grid == 0) {
        int dev = 0, cus = 0, per_cu = 0;
        hipGetDevice(&dev);
        hipDeviceGetAttribute(&cus, hipDeviceAttributeMultiprocessorCount, dev);
        if (hipFuncSetAttribute((const void*)fwd_megakernel, hipFuncAttributeMaxDynamicSharedMemorySize, LDS_BYTES) != hipSuccess) fprintf(stderr, "kernel_launch: hipFuncSetAttribute failed\n");
        if (hipOccupancyMaxActiveBlocksPerMultiprocessor(&per_cu, (const void*)fwd_megakernel, 512, LDS_BYTES) != hipSuccess || per_cu < 1) { fprintf(stderr, "kernel_launch: occupancy query says %d\n", per_cu); per_cu = 1; }
        (void)hipGetLastError();
        grid = cus > 0 ? cus : 256;
        if (n_in != 19 || ws_size < WS_END) fprintf(stderr, "kernel_launch: unexpected n_in %d / ws_size %zu\n", n_in, ws_size);
    }
    Args a{};
    for (int i = 0; i < 19; ++i) a.in[i] = (const float*)d_in[i];
    a.out = (float*)d_out; a.ws = (unsigned char*)d_ws;
#if MK_SPLIT
    for (int p = 0; p < NPH; ++p) { a.ph_lo = p; a.ph_hi = p + 1; hipLaunchKernelGGL(fwd_megakernel, dim3(grid), dim3(512), LDS_BYTES, stream, a); }
#else
    a.ph_lo = 0; a.ph_hi = NPH;
    if (hipMemsetAsync(d_ws, 0, 16384, stream) != hipSuccess) fprintf(stderr, "kernel_launch: memset of the barrier words failed\n");
    void* args[] = {&a};
    hipError_t e = hipLaunchCooperativeKernel((const void*)fwd_megakernel, dim3(grid), dim3(512), args, LDS_BYTES, stream);
    if (e != hipSuccess) fprintf(stderr, "kernel_launch: cooperative launch failed: %s (grid %d)\n", hipGetErrorString(e), grid);
#endif
}
```

```cpp
#include <hip/hip_runtime.h>
#include <hip/hip_cooperative_groups.h>
#include <cstdio>
#include <cstdint>
namespace cg = cooperative_groups;
namespace pg8 {
#define PG8_LAS __attribute__((address_space(3)))
typedef unsigned short bf16_t;
typedef short bf16x8 __attribute__((ext_vector_type(8)));
typedef float f32x4 __attribute__((ext_vector_type(4)));
typedef unsigned u32x4 __attribute__((ext_vector_type(4)));
constexpr int BM = 256, BK = 64, HALF = 128, HTB = HALF * BK * 2  , STAGE_BYTES = 8 * HTB, NXCD = 8, WGM = 8;

__host__ __device__ __forceinline__ int lds_byte(int r, int c) { const int st = (r >> 4) * 2 + (c >> 5), rr = r & 15, cc = c & 31, ob = rr * 64 + cc * 2; return st * 1024 + (ob ^ (((ob >> 9) & 1) << 5)); }
__host__ __device__ __forceinline__ void stage_rc(int b, int& R, int& C) { const int st = b / 1024, sb = b % 1024, swz = sb ^ (((sb >> 9) & 1) << 5); R = (st >> 1) * 16 + swz / 64; C = (st & 1) * 32 + (swz % 64) / 2; }
__host__ __device__ __forceinline__ int perm32(int rho) { const int n = rho >> 4, i = rho & 15; return 8 * (i >> 2) + 4 * n + (i & 3); }

struct Unit { int pm, pn; };
struct Gemm { const bf16_t* A; const bf16_t* Bt; int M, N, K; };

struct StaticOrder {
    int nM, nN, nwg, G, c;
    __host__ __device__ void init(int M, int N, int G_, int c_) { nM = M / BM; nN = N / BM; nwg = nM * nN; G = G_; c = c_; }
    __host__ __device__ bool next(int i, Unit& u) const {
        const long L = (long)i * G + c; if (L >= nwg) return false;
        int wgid = (int)L; { const int q = nwg / NXCD, r = nwg % NXCD, xcd = wgid % NXCD, off = wgid / NXCD; wgid = (xcd < r ? xcd * (q + 1) : r * (q + 1) + (xcd - r) * q) + off; }
        const int nig = WGM * nN, gid = wgid / nig, fm = gid * WGM, gsz = (nM - fm) < WGM ? (nM - fm) : WGM;
        u.pm = fm + ((wgid % nig) % gsz); u.pn = (wgid % nig) / gsz; return true;
    }
    __device__ __forceinline__ void a_ready(const Unit&) const {}
    __device__ __forceinline__ void done(const Unit&) const {}
};
__device__ __forceinline__ unsigned cvt_pk_bf16(float lo, float hi) { unsigned r; asm volatile("v_cvt_pk_bf16_f32 %0, %1, %2" : "=v"(r) : "v"(lo), "v"(hi)); return r; }
template <class Epi, class Sched, bool ALIGN_EPI = false, bool SP2 = false>
__device__ __forceinline__ void gemm_phase(PG8_LAS unsigned char* lds, const Gemm g, const Sched& S, const Epi& E) {
    const int tid = threadIdx.x, wid = __builtin_amdgcn_readfirstlane(tid >> 6), lane = tid & 63, wr = wid >> 2, wc = wid & 3, fr = lane & 15, fq = lane >> 4;
    const int K = g.K, nt = K / BK;
    unsigned voffA[2], voffB[2];
#pragma unroll
    for (int i = 0; i < 2; ++i) { int R, C; stage_rc(tid * 16 + i * 8192, R, C); const int Rb = Epi::PERM ? ((R & ~31) + perm32(R & 31)) : R;
        voffA[i] = (unsigned)(R * K + C) * 2u; voffB[i] = (unsigned)(Rb * K + C) * 2u; }
    const size_t kstep = (size_t)(BK * 2);
    const size_t hstep = (size_t)HALF * K * 2;
    const size_t tstep = 2 * hstep;
    const unsigned ldsw = (unsigned)wid * 1024u;
    const int aoff = lds_byte(wr * 64 + fr, fq * 8), boff = lds_byte(wc * 32 + fr, fq * 8);
#define PG8_SA(b, h) (((b) * 2 + (h)) * HTB)
#define PG8_SB(b, h) ((4 + (b) * 2 + (h)) * HTB)
#define PG8_STAGE(bufoff, gbase, voff) do { _Pragma("unroll") for (int _i = 0; _i < 2; ++_i) \
        __builtin_amdgcn_global_load_lds((const unsigned*)((const char*)(gbase) + (voff)[_i]), (PG8_LAS unsigned*)(lds + (bufoff) + ldsw + _i * 8192), 16, 0, 0); } while (0)
#define PG8_LDA(dst, b, h) do { _Pragma("unroll") for (int m = 0; m < 4; ++m) _Pragma("unroll") for (int k = 0; k < 2; ++k) dst[m][k] = *(const PG8_LAS bf16x8*)(lds + PG8_SA(b, h) + aoff + m * 2048 + k * 1024); } while (0)
#define PG8_LDB(dst, b, h) do { _Pragma("unroll") for (int n = 0; n < 2; ++n) _Pragma("unroll") for (int k = 0; k < 2; ++k) dst[n][k] = *(const PG8_LAS bf16x8*)(lds + PG8_SB(b, h) + boff + n * 2048 + k * 1024); } while (0)
#define PG8_MMA(ai, bj, At, Bt) do { __builtin_amdgcn_s_setprio(1); _Pragma("unroll") for (int m = 0; m < 4; ++m) _Pragma("unroll") for (int n = 0; n < 2; ++n) _Pragma("unroll") for (int k = 0; k < 2; ++k) \
        acc[ai][bj][m][n] = __builtin_amdgcn_mfma_f32_16x16x32_bf16(Bt[n][k], At[m][k], acc[ai][bj][m][n], 0, 0, 0); __builtin_amdgcn_s_setprio(0); } while (0)
#define PG8_WAIT_V(n) asm volatile("s_waitcnt vmcnt(" #n ")" ::: "memory")
#define PG8_WAIT_L(n) asm volatile("s_waitcnt lgkmcnt(" #n ")" ::: "memory")
#define PG8_BAR __builtin_amdgcn_s_barrier()
#define PG8_SCHED __builtin_amdgcn_sched_barrier(0)
    Unit cur, nxt; int ui = 0;
    if (!S.next(0, cur)) return;
    f32x4 acc[2][2][4][2];
#pragma unroll
    for (int a = 0; a < 2; ++a)
#pragma unroll
        for (int b = 0; b < 2; ++b)
#pragma unroll
            for (int m = 0; m < 4; ++m)
#pragma unroll
                for (int n = 0; n < 2; ++n) acc[a][b][m][n] = (f32x4){0.f, 0.f, 0.f, 0.f};
    bf16x8 At[4][2], B0[2][2], B1[2][2];
    const char* cA = (const char*)g.A + (size_t)cur.pm * tstep; const char* cB = (const char*)g.Bt + (size_t)cur.pn * tstep;
    S.a_ready(cur);
    if constexpr (SP2) {
        PG8_STAGE(PG8_SB(0, 0), cB, voffB); PG8_STAGE(PG8_SB(0, 1), cB + hstep, voffB); PG8_STAGE(PG8_SA(0, 0), cA, voffA); PG8_STAGE(PG8_SA(0, 1), cA + hstep, voffA);
        if (wr == 1) PG8_BAR;
        PG8_WAIT_V(2); PG8_BAR;
        PG8_STAGE(PG8_SB(1, 0), cB + kstep, voffB); PG8_STAGE(PG8_SA(1, 0), cA + kstep, voffA); PG8_STAGE(PG8_SB(1, 1), cB + hstep + kstep, voffB);
        PG8_WAIT_V(6); PG8_BAR;
    } else {
        PG8_STAGE(PG8_SB(0, 0), cB, voffB); PG8_STAGE(PG8_SA(0, 0), cA, voffA); PG8_STAGE(PG8_SB(0, 1), cB + hstep, voffB); PG8_STAGE(PG8_SA(0, 1), cA + hstep, voffA);
        if (wr == 1) PG8_BAR;
        PG8_WAIT_V(4); PG8_BAR;
        PG8_STAGE(PG8_SB(1, 0), cB + kstep, voffB); PG8_STAGE(PG8_SA(1, 0), cA + kstep, voffA); PG8_STAGE(PG8_SB(1, 1), cB + hstep + kstep, voffB);
        PG8_WAIT_V(6); PG8_BAR;
    }
    for (;;) {
        const bool has_next = S.next(ui + 1, nxt);
        const char* nA = has_next ? (const char*)g.A + (size_t)nxt.pm * tstep : cA; const char* nB = has_next ? (const char*)g.Bt + (size_t)nxt.pn * tstep : cB;
        for (int t = 0; t < nt; t += 2) {
            const bool last = (t == nt - 2);
            const char* a1 = cA + (size_t)(t + 1) * kstep;
            const char* a2 = last ? nA : cA + (size_t)(t + 2) * kstep; const char* b2 = last ? nB : cB + (size_t)(t + 2) * kstep;
            const char* a3 = a2 + kstep; const char* b3 = b2 + kstep;
            if (last && has_next) S.a_ready(nxt);
            if constexpr (SP2) {
            PG8_LDB(B0, 0, 0); PG8_LDB(B1, 0, 1); PG8_SCHED; PG8_LDA(At, 0, 0); PG8_STAGE(PG8_SA(1, 1), a1 + hstep, voffA);
            PG8_WAIT_V(8); PG8_WAIT_L(0); PG8_BAR; PG8_MMA(0, 0, At, B0); PG8_MMA(0, 1, At, B1); PG8_BAR; PG8_SCHED;
            PG8_LDA(At, 0, 1); PG8_STAGE(PG8_SB(0, 0), b2, voffB); PG8_STAGE(PG8_SB(0, 1), b2 + hstep, voffB); PG8_STAGE(PG8_SA(0, 0), a2, voffA);
            PG8_WAIT_V(8); PG8_WAIT_L(0); PG8_BAR; PG8_MMA(1, 0, At, B0); PG8_MMA(1, 1, At, B1); PG8_BAR; PG8_SCHED;
            PG8_LDB(B0, 1, 0); PG8_LDB(B1, 1, 1); PG8_SCHED; PG8_LDA(At, 1, 0); PG8_STAGE(PG8_SA(0, 1), a2 + hstep, voffA);
            PG8_WAIT_V(8); PG8_WAIT_L(0); PG8_BAR; PG8_MMA(0, 0, At, B0); PG8_MMA(0, 1, At, B1); PG8_BAR; PG8_SCHED;
            PG8_LDA(At, 1, 1); PG8_STAGE(PG8_SB(1, 0), b3, voffB); PG8_STAGE(PG8_SB(1, 1), b3 + hstep, voffB); PG8_STAGE(PG8_SA(1, 0), a3, voffA);
            PG8_WAIT_V(8); PG8_WAIT_L(0); PG8_BAR; PG8_MMA(1, 0, At, B0); PG8_MMA(1, 1, At, B1); PG8_BAR; PG8_SCHED;
            } else {
            PG8_LDB(B0, 0, 0); PG8_SCHED; PG8_LDA(At, 0, 0); PG8_STAGE(PG8_SA(1, 1), a1 + hstep, voffA);
            PG8_WAIT_L(8); PG8_BAR; PG8_WAIT_L(0); PG8_MMA(0, 0, At, B0); PG8_BAR; PG8_SCHED;
            PG8_LDB(B1, 0, 1); PG8_STAGE(PG8_SB(0, 0), b2, voffB);
            PG8_BAR; PG8_WAIT_L(0); PG8_MMA(0, 1, At, B1); PG8_BAR;
            PG8_LDA(At, 0, 1); PG8_STAGE(PG8_SA(0, 0), a2, voffA);
            PG8_BAR; PG8_WAIT_L(0); PG8_MMA(1, 0, At, B0); PG8_BAR; PG8_SCHED;
            PG8_STAGE(PG8_SB(0, 1), b2 + hstep, voffB);
            PG8_WAIT_V(6); PG8_BAR; PG8_MMA(1, 1, At, B1); PG8_BAR;
            PG8_LDB(B0, 1, 0); PG8_SCHED; PG8_LDA(At, 1, 0); PG8_STAGE(PG8_SA(0, 1), a2 + hstep, voffA);
            PG8_WAIT_L(8); PG8_BAR; PG8_WAIT_L(0); PG8_MMA(0, 0, At, B0); PG8_BAR; PG8_SCHED;
            PG8_LDB(B1, 1, 1); PG8_STAGE(PG8_SB(1, 0), b3, voffB);
            PG8_BAR; PG8_WAIT_L(0); PG8_MMA(0, 1, At, B1); PG8_BAR;
            PG8_LDA(At, 1, 1); PG8_STAGE(PG8_SA(1, 0), a3, voffA);
            PG8_BAR; PG8_WAIT_L(0); PG8_MMA(1, 0, At, B0); PG8_BAR; PG8_SCHED;
            PG8_STAGE(PG8_SB(1, 1), b3 + hstep, voffB);
            PG8_WAIT_V(6); PG8_BAR; PG8_MMA(1, 1, At, B1); PG8_BAR;
            }
        }
        if constexpr (ALIGN_EPI) { if (wr == 0) PG8_BAR; }
        if constexpr (!Epi::AFTER_DRAIN) { E(acc, cur, wr, wc, fr, fq); S.done(cur); }
        if (!has_next) break;
#pragma unroll
        for (int a = 0; a < 2; ++a)
#pragma unroll
            for (int b = 0; b < 2; ++b)
#pragma unroll
                for (int m = 0; m < 4; ++m)
#pragma unroll
                    for (int n = 0; n < 2; ++n) acc[a][b][m][n] = (f32x4){0.f, 0.f, 0.f, 0.f};
        cur = nxt; cA = nA; cB = nB; ++ui;
        if constexpr (ALIGN_EPI) { if (wr == 1) PG8_BAR; }
    }
    PG8_WAIT_V(0);
    if constexpr (!ALIGN_EPI) { if (wr == 0) PG8_BAR; }
    PG8_BAR;
    if constexpr (Epi::AFTER_DRAIN) { E.fused(acc, cur, wr, wc, fr, fq, lds, wid, lane); S.done(cur); }
#undef PG8_SA
#undef PG8_SB
#undef PG8_STAGE
#undef PG8_LDA
#undef PG8_LDB
#undef PG8_MMA
#undef PG8_WAIT_V
#undef PG8_WAIT_L
#undef PG8_BAR
#undef PG8_SCHED
}
}

constexpr int SEQ = 8192, BATCH = 2, M = BATCH * SEQ, D = 1024, DIN = 2560, FF = 4096, NMEM = 256, MM = BATCH * NMEM;
constexpr float EPS = 1e-6f;
constexpr float LOG2E = 1.4426950408889634f;
constexpr float QSCALE = 0.125f * LOG2E;
constexpr float XQSCALE = 0.0625f * LOG2E;

typedef unsigned short bf16_t;
using pg8::bf16x8; using pg8::f32x4; using pg8::u32x4;
typedef short s16x4 __attribute__((ext_vector_type(4)));
typedef short v4i16_t __attribute__((ext_vector_type(4)));
typedef float f32x2 __attribute__((ext_vector_type(2)));
typedef unsigned u32x2 __attribute__((ext_vector_type(2)));
#define LAS __attribute__((address_space(3)))

constexpr size_t MiB = 1u << 20;
constexpr size_t WS_CS = 1 * MiB, WS_SS1 = 2 * MiB, WS_SS2 = 3 * MiB, WS_SS3 = 4 * MiB, WS_LSE = 5 * MiB, WS_MN = 7 * MiB, WS_XK = 8 * MiB, WS_XV = 9 * MiB;
constexpr size_t WS_WIN = 10 * MiB, WS_WOUT = 15 * MiB, WS_WXQ = 17 * MiB, WS_WXKV = 19 * MiB, WS_WXO = 23 * MiB, WS_WUP = 25 * MiB, WS_WDN = 33 * MiB;
constexpr size_t WS_XN = 42 * MiB, WS_QB = 74 * MiB, WS_KB = 90 * MiB, WS_VB = 106 * MiB, WS_UC = 122 * MiB, WS_MIX = 138 * MiB, WS_OP = 170 * MiB;
constexpr size_t WS_XQ = 74 * MiB, WS_XO = 106 * MiB, WS_U = 74 * MiB, WS_END = 218 * MiB;
constexpr int LDS_BYTES = 163840;
constexpr int NPH = 11;

struct Args { const float* in[19]; float* out; unsigned char* ws; int ph_lo, ph_hi; };

__device__ __forceinline__ unsigned pk2(float lo, float hi) { return pg8::cvt_pk_bf16(lo, hi); }
__device__ __forceinline__ float bflo(unsigned w) { return __uint_as_float(w << 16); }
__device__ __forceinline__ float bfhi(unsigned w) { return __uint_as_float(w & 0xffff0000u); }
__device__ __forceinline__ float wave_sum(float v) {
#pragma unroll
    for (int o = 1; o < 64; o <<= 1) v += __shfl_xor(v, o);
    return v;
}
#define MFMA16(a, b, c) __builtin_amdgcn_mfma_f32_16x16x32_bf16((a), (b), (c), 0, 0, 0)
__device__ __forceinline__ s16x4 vtr(const LAS unsigned char* p) { return __builtin_bit_cast(s16x4, __builtin_amdgcn_ds_read_tr16_b64_v4i16((LAS v4i16_t*)p)); }

struct EpiIn {
    static constexpr bool PERM = true, AFTER_DRAIN = false;
    bf16_t *Qb, *Kb, *Vb, *UC; const float* CS;
    __device__ __forceinline__ void operator()(const f32x4 (&acc)[2][2][4][2], const pg8::Unit& u, int wr, int wc, int fr, int fq) const {
        const int row0 = u.pm * 256 + wr * 64 + fr;
        if (u.pn >= 6) {
            const int ch0 = (u.pn - 6) * 128 + wc * 32 + 8 * fq;
#pragma unroll
            for (int ai = 0; ai < 2; ++ai)
#pragma unroll
                for (int m = 0; m < 4; ++m) {
                    const int row = row0 + ai * 128 + m * 16;
                    float r[8];
#pragma unroll
                    for (int n = 0; n < 2; ++n)
#pragma unroll
                        for (int j = 0; j < 4; ++j) { const float a = acc[ai][0][m][n][j], g = acc[ai][1][m][n][j]; r[4 * n + j] = a * __builtin_amdgcn_rcpf(1.f + __expf(-g)); }
                    u32x4 w; w.x = pk2(r[0], r[1]); w.y = pk2(r[2], r[3]); w.z = pk2(r[4], r[5]); w.w = pk2(r[6], r[7]);
                    *(u32x4*)(UC + (size_t)row * 512 + ch0) = w;
                }
        } else if (u.pn >= 4) {
            const int col0 = (u.pn - 4) * 256 + wc * 32 + 8 * fq;
#pragma unroll
            for (int ai = 0; ai < 2; ++ai)
#pragma unroll
                for (int m = 0; m < 4; ++m) {
                    const int row = row0 + ai * 128 + m * 16;
#pragma unroll
                    for (int bj = 0; bj < 2; ++bj) {
                        const f32x4 v0 = acc[ai][bj][m][0], v1 = acc[ai][bj][m][1];
                        u32x4 w; w.x = pk2(v0[0], v0[1]); w.y = pk2(v0[2], v0[3]); w.z = pk2(v1[0], v1[1]); w.w = pk2(v1[2], v1[3]);
                        *(u32x4*)(Vb + (size_t)row * 512 + col0 + bj * 128) = w;
                    }
                }
        } else {
            bf16_t* dst = (u.pn < 2) ? Qb : Kb; const float sc = (u.pn < 2) ? QSCALE : 1.f;
            const int col0 = (u.pn & 1) * 256 + wc * 32 + 8 * fq;
            const bool rope_wave = (wc & 1) == 0;
            const float sgn = (fq == 0) ? -1.f : 1.f;
#pragma unroll
            for (int ai = 0; ai < 2; ++ai)
#pragma unroll
                for (int m = 0; m < 4; ++m) {
                    const int row = row0 + ai * 128 + m * 16;
                    const int pos = row & (SEQ - 1);
                    f32x4 cs[4];
                    if (rope_wave && fq < 2) {
#pragma unroll
                        for (int q = 0; q < 4; ++q) cs[q] = *(const f32x4*)(CS + (size_t)pos * 16 + 4 * q);
                    }
#pragma unroll
                    for (int bj = 0; bj < 2; ++bj) {
                        float v[8];
#pragma unroll
                        for (int n = 0; n < 2; ++n)
#pragma unroll
                            for (int j = 0; j < 4; ++j) v[4 * n + j] = acc[ai][bj][m][n][j];
                        if (rope_wave) {
#pragma unroll
                            for (int i = 0; i < 8; ++i) {
                                const float p = __shfl_xor(v[i], 16);
                                if (fq < 2) { const float c = cs[i >> 1][2 * (i & 1)], s = cs[i >> 1][2 * (i & 1) + 1]; v[i] = v[i] * c + sgn * p * s; }
                            }
                        }
                        u32x4 w; w.x = pk2(v[0] * sc, v[1] * sc); w.y = pk2(v[2] * sc, v[3] * sc); w.z = pk2(v[4] * sc, v[5] * sc); w.w = pk2(v[6] * sc, v[7] * sc);
                        *(u32x4*)(dst + (size_t)row * 512 + col0 + bj * 128) = w;
                    }
                }
        }
    }
};
struct EpiKV {
    static constexpr bool PERM = true, AFTER_DRAIN = false;
    bf16_t *XK, *XV;
    __device__ __forceinline__ void operator()(const f32x4 (&acc)[2][2][4][2], const pg8::Unit& u, int wr, int wc, int fr, int fq) const {
        const int row0 = u.pm * 256 + wr * 64 + fr;
        bf16_t* dst = (u.pn < 4) ? XK : XV; const int col0 = (u.pn & 3) * 256 + wc * 32 + 8 * fq;
#pragma unroll
        for (int ai = 0; ai < 2; ++ai)
#pragma unroll
            for (int m = 0; m < 4; ++m) {
                const int row = row0 + ai * 128 + m * 16;
#pragma unroll
                for (int bj = 0; bj < 2; ++bj) {
                    const f32x4 v0 = acc[ai][bj][m][0], v1 = acc[ai][bj][m][1];
                    u32x4 w; w.x = pk2(v0[0], v0[1]); w.y = pk2(v0[2], v0[3]); w.z = pk2(v1[0], v1[1]); w.w = pk2(v1[2], v1[3]);
                    *(u32x4*)(dst + (size_t)row * 1024 + col0 + bj * 128) = w;
                }
            }
    }
};
template <bool BASE_BF16, bool OUT_F32, bool OUT_BF16> struct EpiRes {
    static constexpr bool PERM = true, AFTER_DRAIN = false;
    const float* base; const bf16_t* baseb; float* out; bf16_t* xn; float* ss;
    __device__ __forceinline__ void operator()(const f32x4 (&acc)[2][2][4][2], const pg8::Unit& u, int wr, int wc, int fr, int fq) const {
        const int row0 = u.pm * 256 + wr * 64 + fr; const int col0 = u.pn * 256 + wc * 32 + 8 * fq;
#pragma unroll
        for (int ai = 0; ai < 2; ++ai)
#pragma unroll
            for (int m = 0; m < 4; ++m) {
                const int row = row0 + ai * 128 + m * 16;
                float s = 0.f;
#pragma unroll
                for (int bj = 0; bj < 2; ++bj) {
                    const size_t o = (size_t)row * D + col0 + bj * 128;
                    f32x4 b0, b1;
                    if (BASE_BF16) { const u32x4 bw = *(const u32x4*)(baseb + o); b0 = (f32x4){bflo(bw.x), bfhi(bw.x), bflo(bw.y), bfhi(bw.y)}; b1 = (f32x4){bflo(bw.z), bfhi(bw.z), bflo(bw.w), bfhi(bw.w)}; }
                    else { b0 = *(const f32x4*)(base + o); b1 = *(const f32x4*)(base + o + 4); }
                    const f32x4 v0 = acc[ai][bj][m][0] + b0, v1 = acc[ai][bj][m][1] + b1;
                    if (OUT_F32) { *(f32x4*)(out + o) = v0; *(f32x4*)(out + o + 4) = v1; }
                    if (OUT_BF16) { u32x4 w; w.x = pk2(v0[0], v0[1]); w.y = pk2(v0[2], v0[3]); w.z = pk2(v1[0], v1[1]); w.w = pk2(v1[2], v1[3]); *(u32x4*)(xn + o) = w; }
                    s += (v0[0] * v0[0] + v0[1] * v0[1]) + (v0[2] * v0[2] + v0[3] * v0[3]) + (v1[0] * v1[0] + v1[1] * v1[1]) + (v1[2] * v1[2] + v1[3] * v1[3]);
                }
                s += __shfl_xor(s, 16); s += __shfl_xor(s, 32);
                if (fq == 0) ss[(size_t)row * 16 + u.pn * 4 + wc] = s;
            }
    }
};
template <int ACT> struct EpiScale {
    static constexpr bool PERM = true, AFTER_DRAIN = false;
    bf16_t* O; int ldc; const float* ss; float scale;
    __device__ __forceinline__ void operator()(const f32x4 (&acc)[2][2][4][2], const pg8::Unit& u, int wr, int wc, int fr, int fq) const {
        const int row0 = u.pm * 256 + wr * 64 + fr; const int col0 = u.pn * 256 + wc * 32 + 8 * fq;
#pragma unroll
        for (int ai = 0; ai < 2; ++ai)
#pragma unroll
            for (int m = 0; m < 4; ++m) {
                const int row = row0 + ai * 128 + m * 16;
                const f32x4 s0 = *(const f32x4*)(ss + (size_t)row * 16), s1 = *(const f32x4*)(ss + (size_t)row * 16 + 4), s2 = *(const f32x4*)(ss + (size_t)row * 16 + 8), s3 = *(const f32x4*)(ss + (size_t)row * 16 + 12);
                const f32x4 st = (s0 + s1) + (s2 + s3);
                const float rstd = rsqrtf(((st[0] + st[1]) + (st[2] + st[3])) * (1.f / D) + EPS) * scale;
#pragma unroll
                for (int bj = 0; bj < 2; ++bj) {
                    f32x4 v0 = acc[ai][bj][m][0] * rstd, v1 = acc[ai][bj][m][1] * rstd;
                    if (ACT == 1) {
#pragma unroll
                        for (int j = 0; j < 4; ++j) { const float a = fmaxf(v0[j], 0.f), b = fmaxf(v1[j], 0.f); v0[j] = a * a; v1[j] = b * b; }
                    }
                    u32x4 w; w.x = pk2(v0[0], v0[1]); w.y = pk2(v0[2], v0[3]); w.z = pk2(v1[0], v1[1]); w.w = pk2(v1[2], v1[3]);
                    *(u32x4*)(O + (size_t)row * ldc + col0 + bj * 128) = w;
                }
            }
    }
};

__device__ __forceinline__ void p0_transpose_item(const float* __restrict__ W, int K, int N, bf16_t* WT, int dest_row0, const float* __restrict__ gk, LAS float* scr, int k0, int n0, int lane) {
    const float* wp = W + (size_t)(k0 + (lane >> 5)) * N + n0 + (lane & 31);
    float v[32];
#pragma unroll
    for (int i = 0; i < 32; ++i) v[i] = wp[(size_t)(2 * i) * N];
    const int c = lane & 7;
    f32x4 g0 = {1.f, 1.f, 1.f, 1.f}, g1 = {1.f, 1.f, 1.f, 1.f};
    if (gk) { g0 = *(const f32x4*)(gk + k0 + 8 * c); g1 = *(const f32x4*)(gk + k0 + 8 * c + 4); }
#pragma unroll
    for (int i = 0; i < 32; ++i) scr[(2 * i + (lane >> 5)) * 33 + (lane & 31)] = v[i];
    asm volatile("s_waitcnt lgkmcnt(0)" ::: "memory");
#pragma unroll
    for (int j = 0; j < 4; ++j) { const int n = (lane >> 3) + 8 * j; const LAS float* s = scr + (8 * c) * 33 + n;
        u32x4 o; o.x = pk2(s[0 * 33] * g0[0], s[1 * 33] * g0[1]); o.y = pk2(s[2 * 33] * g0[2], s[3 * 33] * g0[3]); o.z = pk2(s[4 * 33] * g1[0], s[5 * 33] * g1[1]); o.w = pk2(s[6 * 33] * g1[2], s[7 * 33] * g1[3]);
        *(u32x4*)(WT + (size_t)(dest_row0 + n) * K + k0 + 8 * c) = o; }
    asm volatile("s_waitcnt lgkmcnt(0)" ::: "memory");
}
__device__ __forceinline__ int win_dest_row(int n0) {
    if (n0 < 1536) return n0;
    const int cc = n0 - 1536, isg = cc >= 512, ch = cc & 511;
    return 1536 + 256 * (ch >> 7) + 128 * isg + (ch & 127);
}
__device__ __forceinline__ void rms_rows_to_bf16(const float* __restrict__ x, const float* __restrict__ g, bf16_t* o, int first, int stride, int nrows, int lane) {
    if (first >= nrows) return;
    f32x4 gg[4], cur[4], nxt[4];
#pragma unroll
    for (int j = 0; j < 4; ++j) { gg[j] = *(const f32x4*)(g + 4 * lane + 256 * j); cur[j] = *(const f32x4*)(x + (size_t)first * D + 4 * lane + 256 * j); nxt[j] = cur[j]; }
#pragma unroll 1
    for (int m = first; m < nrows; m += stride) {
        const int mn = m + stride;
        if (mn < nrows) {
#pragma unroll
            for (int j = 0; j < 4; ++j) nxt[j] = *(const f32x4*)(x + (size_t)mn * D + 4 * lane + 256 * j);
        }
        float s = 0.f;
#pragma unroll
        for (int j = 0; j < 4; ++j) s += (cur[j][0] * cur[j][0] + cur[j][1] * cur[j][1]) + (cur[j][2] * cur[j][2] + cur[j][3] * cur[j][3]);
        const float rstd = rsqrtf(wave_sum(s) * (1.f / D) + EPS);
#pragma unroll
        for (int j = 0; j < 4; ++j) { const f32x4 y = cur[j] * rstd * gg[j];
            u32x2 w; w.x = pk2(y[0], y[1]); w.y = pk2(y[2], y[3]); *(u32x2*)(o + (size_t)m * D + 4 * lane + 256 * j) = w; cur[j] = nxt[j]; }
    }
}
__device__ __forceinline__ void p0_prologue(LAS unsigned char* lds, const Args& a, int tid) {
    const int lane = tid & 63, wave = __builtin_amdgcn_readfirstlane(tid >> 6);
    LAS float* scr = (LAS float*)(lds + wave * 16384);
    const int gw = blockIdx.x * 8 + wave, NGW = gridDim.x * 8;
    unsigned char* ws = a.ws;
    constexpr int I_IN = 16 * 80, I_SQ = 16 * 32;
    constexpr int NITEMS = I_IN + 2 * I_SQ;
    for (int it = gw; it < NITEMS; it += NGW) {
        int r = it;
        if (r < I_IN) { const int kb = r / 80, nb = r % 80; p0_transpose_item(a.in[3], D, DIN, (bf16_t*)(ws + WS_WIN), win_dest_row(32 * nb), nullptr, scr, 64 * kb, 32 * nb, lane); continue; } r -= I_IN;
        if (r < I_SQ) { p0_transpose_item(a.in[12], D, D, (bf16_t*)(ws + WS_WXKV), 32 * (r % 32), nullptr, scr, 64 * (r / 32), 32 * (r % 32), lane); continue; } r -= I_SQ;
        p0_transpose_item(a.in[13], D, D, (bf16_t*)(ws + WS_WXKV), 1024 + 32 * (r % 32), nullptr, scr, 64 * (r / 32), 32 * (r % 32), lane);
    }
    rms_rows_to_bf16(a.in[0], a.in[2], (bf16_t*)(ws + WS_XN), gw, NGW, M, lane);
    rms_rows_to_bf16(a.in[1], a.in[10], (bf16_t*)(ws + WS_MN), gw, NGW, MM, lane);
    float* CS = (float*)(ws + WS_CS);
    for (int idx = blockIdx.x * 512 + tid; idx < SEQ * 8; idx += gridDim.x * 512) {
        const int pos = idx >> 3, i = idx & 7;
        const float freq = powf(500000.0f, -(float)(2 * i) / 16.0f);
        const float ang = (float)pos * freq;
        CS[2 * idx] = cosf(ang); CS[2 * idx + 1] = sinf(ang);
    }
}

__device__ __forceinline__ void late_weights(LAS unsigned char* lds, const Args& a, int tid, int hw, int nh) {
    const int lane = tid & 63, wave = __builtin_amdgcn_readfirstlane(tid >> 6);
    LAS float* scr = (LAS float*)(lds + wave * 16384);
    const int gw = hw * 8 + wave, NGW = nh * 8;
    unsigned char* ws = a.ws;
    constexpr int I_SQ = 16 * 32, I_UP = 16 * 128, I_DN = 64 * 32;
    constexpr int NITEMS = 3 * I_SQ + I_UP + I_DN;
    for (int it = gw; it < NITEMS; it += NGW) {
        int r = it;
        if (r < I_SQ) { p0_transpose_item(a.in[8], D, D, (bf16_t*)(ws + WS_WOUT), 32 * (r % 32), nullptr, scr, 64 * (r / 32), 32 * (r % 32), lane); continue; } r -= I_SQ;
        if (r < I_SQ) { p0_transpose_item(a.in[11], D, D, (bf16_t*)(ws + WS_WXQ), 32 * (r % 32), a.in[9], scr, 64 * (r / 32), 32 * (r % 32), lane); continue; } r -= I_SQ;
        if (r < I_SQ) { p0_transpose_item(a.in[14], D, D, (bf16_t*)(ws + WS_WXO), 32 * (r % 32), nullptr, scr, 64 * (r / 32), 32 * (r % 32), lane); continue; } r -= I_SQ;
        if (r < I_UP) { p0_transpose_item(a.in[16], D, FF, (bf16_t*)(ws + WS_WUP), 32 * (r % 128), a.in[15], scr, 64 * (r / 128), 32 * (r % 128), lane); continue; } r -= I_UP;
        p0_transpose_item(a.in[17], FF, D, (bf16_t*)(ws + WS_WDN), 32 * (r % 32), nullptr, scr, 64 * (r / 32), 32 * (r % 32), lane);
    }
}

constexpr int KV_ROWS = 272, KV_PITCH = 144, KV_BYTES = KV_ROWS * KV_PITCH, KV_IMG = 2 * KV_BYTES + KV_ROWS * 4;
static_assert(2 * KV_IMG <= LDS_BYTES - 64, "two dattn images fit");
constexpr int N_DATTN_UNITS = BATCH * 8 * 192;
struct DUnit { int h, d, L, r, j0, pat; size_t rowbase; };
__device__ __forceinline__ DUnit dattn_decode(int unit) {
    DUnit u; const int bh = unit / 192, rem = unit % 192, blk = rem % 64; u.pat = rem / 64;
    u.h = bh & 7; u.rowbase = (size_t)(bh >> 3) * SEQ;
    const int dsh = 2 * u.pat; u.d = 1 << dsh; u.L = SEQ >> dsh; const int nblk = u.L >> 7;
    u.r = blk / nblk; u.j0 = (blk % nblk) * 128; return u;
}
__device__ __forceinline__ int dattn_row(int i, int tid) { return (tid >> 3) + (i < 4 ? 64 * i : (i == 4 ? (tid < 128 ? 256 : -16) : 64 * (i - 5) + 48)); }
__device__ __forceinline__ void dattn_issue(const DUnit& u, const bf16_t* __restrict__ Qb, const bf16_t* __restrict__ Kb, const bf16_t* __restrict__ Vb, u32x4 (&kv)[9], bf16x8& qf0, bf16x8& qf1, int tid, int w, int ql, int g) {
    const unsigned stride = (unsigned)u.d * 1024u;
    const char* kbase = (const char*)(Kb + (u.rowbase + u.r) * 512 + u.h * 64);
    const char* vbase = (const char*)(Vb + (u.rowbase + u.r) * 512 + u.h * 64);
    const unsigned chb = (unsigned)(tid & 7) * 16u;
#pragma unroll
    for (int i = 0; i < 9; ++i) {
        int j = u.j0 - 64 + dattn_row(i, tid); j = j < 0 ? 0 : (j > u.L - 1 ? u.L - 1 : j);
        const unsigned off = (unsigned)j * stride + chb;
        const char* base = (i < 4) ? kbase : ((i > 4) ? vbase : (tid < 128 ? kbase : vbase));
        if (i < 8 || tid < 256) kv[i] = *(const u32x4*)(base + off);
    }
    const size_t qrow = u.rowbase + (size_t)(u.j0 + 16 * w + ql) * u.d + u.r;
    const bf16_t* qp = Qb + qrow * 512 + u.h * 64 + 8 * g;
    qf0 = *(const bf16x8*)qp; qf1 = *(const bf16x8*)(qp + 32);
}
struct DOut { u32x2 v[4]; float lse; bf16_t* op; float* lp; };
__device__ __forceinline__ void dattn_store(const DOut& o, int g) {
#pragma unroll
    for (int dt = 0; dt < 4; ++dt) *(u32x2*)(o.op + 16 * dt) = o.v[dt];
    if (g == 0) *o.lp = o.lse;
}
__device__ __forceinline__ void dattn_compute(LAS unsigned char* img, const DUnit& u, const bf16x8 qf0, const bf16x8 qf1, bf16_t* OP, float* LSE, int w, int ql, int g, DOut& out) {
    const int jq = u.j0 + 16 * w + ql; const size_t qrow = u.rowbase + (size_t)jq * u.d + u.r;
    f32x4 st[9];
    const LAS unsigned char* kp = img + (16 * w + ql) * KV_PITCH + g * 16;
    const LAS unsigned char* bp = img + 2 * KV_BYTES + (16 * w + 4 * g) * 4;
    const int dbase = 4 * g - 64 - ql;
#pragma unroll
    for (int t = 0; t < 9; ++t) {
        const bf16x8 k0 = *(const LAS bf16x8*)(kp + t * 16 * KV_PITCH), k1 = *(const LAS bf16x8*)(kp + t * 16 * KV_PITCH + 64);
        f32x4 z = *(const LAS f32x4*)(bp + t * 64);
        if (t == 0) {
#pragma unroll
            for (int i = 0; i < 4; ++i) z[i] = (dbase + i >= -64) ? z[i] : -1e30f;
        }
        if (t == 8) {
#pragma unroll
            for (int i = 0; i < 4; ++i) z[i] = (dbase + 128 + i <= 64) ? z[i] : -1e30f;
        }
        z = MFMA16(k0, qf0, z); st[t] = MFMA16(k1, qf1, z);
    }
    float mx = -1e30f;
#pragma unroll
    for (int t = 0; t < 9; ++t) mx = fmaxf(mx, fmaxf(fmaxf(st[t][0], st[t][1]), fmaxf(st[t][2], st[t][3])));
    mx = fmaxf(mx, __shfl_xor(mx, 16)); mx = fmaxf(mx, __shfl_xor(mx, 32));
    float lsum = 0.f;
#pragma unroll
    for (int t = 0; t < 9; ++t)
#pragma unroll
        for (int i = 0; i < 4; ++i) { const float p = __builtin_amdgcn_exp2f(st[t][i] - mx); st[t][i] = p; lsum += p; }
    lsum += __shfl_xor(lsum, 16); lsum += __shfl_xor(lsum, 32);
    bf16x8 pf[5];
#pragma unroll
    for (int s = 0; s < 5; ++s) {
        u32x4 wv; wv.x = pk2(st[2 * s][0], st[2 * s][1]); wv.y = pk2(st[2 * s][2], st[2 * s][3]);
        if (2 * s + 1 < 9) { wv.z = pk2(st[(2 * s + 1) % 9][0], st[(2 * s + 1) % 9][1]); wv.w = pk2(st[(2 * s + 1) % 9][2], st[(2 * s + 1) % 9][3]); } else { wv.z = 0u; wv.w = 0u; }
        pf[s] = __builtin_bit_cast(bf16x8, wv);
    }
    f32x4 o[4];
#pragma unroll
    for (int dt = 0; dt < 4; ++dt) o[dt] = (f32x4){0.f, 0.f, 0.f, 0.f};
    const LAS unsigned char* vp = img + KV_BYTES + (16 * w + 4 * g + (ql >> 2)) * KV_PITCH + (ql & 3) * 8;
#pragma unroll
    for (int s = 0; s < 5; ++s)
#pragma unroll
        for (int dt = 0; dt < 4; ++dt) {
            const s16x4 lo = vtr(vp + (32 * s) * KV_PITCH + dt * 32), hi = vtr(vp + (32 * s + 16) * KV_PITCH + dt * 32);
            const bf16x8 vf = {lo[0], lo[1], lo[2], lo[3], hi[0], hi[1], hi[2], hi[3]};
            o[dt] = MFMA16(vf, pf[s], o[dt]);
        }
    const float inv = __builtin_amdgcn_rcpf(lsum);
    out.op = OP + (size_t)u.pat * M * 512 + qrow * 512 + u.h * 64 + 4 * g;
#pragma unroll
    for (int dt = 0; dt < 4; ++dt) { u32x2 wv; wv.x = pk2(o[dt][0] * inv, o[dt][1] * inv); wv.y = pk2(o[dt][2] * inv, o[dt][3] * inv); out.v[dt] = wv; }
    out.lp = LSE + (size_t)u.pat * M * 8 + qrow * 8 + u.h; out.lse = mx + __builtin_amdgcn_logf(lsum);
}
__device__ __forceinline__ void dattn_phase(LAS unsigned char* lds, const bf16_t* __restrict__ Qb, const bf16_t* __restrict__ Kb, const bf16_t* __restrict__ Vb, bf16_t* OP, float* LSE, int c0, int G, int tid) {
    const int lane = tid & 63, w = __builtin_amdgcn_readfirstlane(tid >> 6), ql = lane & 15, g = lane >> 4;
    int un = c0; if (un >= N_DATTN_UNITS) return;
    u32x4 kv[9]; bf16x8 qn0, qn1;
    DUnit cur = dattn_decode(un);
    dattn_issue(cur, Qb, Kb, Vb, kv, qn0, qn1, tid, w, ql, g);
    int buf = 0; bool pend = false; DOut po;
    const int wbase = (tid >> 3) * KV_PITCH + (tid & 7) * 16;
#pragma unroll 1
    for (;;) {
        LAS unsigned char* img = lds + buf * KV_IMG;
        LAS unsigned char* wk = img + wbase; LAS unsigned char* wv = img + KV_BYTES + wbase;
#pragma unroll
        for (int i = 0; i < 9; ++i) {
            if (i < 4) *(LAS u32x4*)(wk + 64 * i * KV_PITCH) = kv[i];
            else if (i == 4) { if (tid < 128) *(LAS u32x4*)(wk + 256 * KV_PITCH) = kv[i]; else *(LAS u32x4*)(wv - 16 * KV_PITCH) = kv[i]; }
            else if (i < 8 || tid < 256) *(LAS u32x4*)(wv + (64 * (i - 5) + 48) * KV_PITCH) = kv[i];
        }
        if (tid < KV_ROWS) { const int j = cur.j0 - 64 + tid; *(LAS float*)(img + 2 * KV_BYTES + tid * 4) = (j >= 0 && j < cur.L) ? 0.f : -1e30f; }
        const bf16x8 q0 = qn0, q1 = qn1;
        __syncthreads();
        if (pend) dattn_store(po, g);
        un += G; const bool has = un < N_DATTN_UNITS;
        DUnit nxt = cur;
        if (has) { nxt = dattn_decode(un); dattn_issue(nxt, Qb, Kb, Vb, kv, qn0, qn1, tid, w, ql, g); }
        dattn_compute(img, cur, q0, q1, OP, LSE, w, ql, g, po); pend = true;
        if (!has) break;
        cur = nxt; buf ^= 1;
    }
    dattn_store(po, g);
    __syncthreads();
}

constexpr int N_CONV_UNITS = M / 32;
__device__ __forceinline__ void conv_issue(const bf16_t* __restrict__ UC, int unit, u32x4 (&tmp)[8], int tid) {
    const int p0 = unit * 32, b = p0 >> 13, t0 = p0 & (SEQ - 1);
#pragma unroll
    for (int i = 0; i < 8; ++i) { const int c = tid + 512 * i; const int row = c >> 6, ch = c & 63, t = t0 - 15 + row;
        u32x4 v = {0u, 0u, 0u, 0u};
        if (c < 62 * 64 && t >= 0 && t < SEQ) v = *(const u32x4*)(UC + ((size_t)b * SEQ + t) * 512 + ch * 8);
        tmp[i] = v; }
}
__device__ __forceinline__ void conv_phase(LAS unsigned char* lds, const bf16_t* __restrict__ UC, const float* __restrict__ cw, const float* __restrict__ cb, const float* __restrict__ lg, const float* __restrict__ lb, bf16_t* MIX, int c0, int G, int tid) {
    int unit = c0; if (unit >= N_CONV_UNITS) return;
    LAS unsigned char* ut = lds; LAS float* ot = (LAS float*)(lds + 63488);
    u32x4 tmp[8];
    conv_issue(UC, unit, tmp, tid);
    const int cp = tid & 255, half = tid >> 8;
    const int lane = tid & 63, w = tid >> 6;
    f32x2 wk[31];
#pragma unroll
    for (int k = 0; k < 31; ++k) wk[k] = *(const f32x2*)(cw + k * 512 + 2 * cp);
    const f32x2 bias = *(const f32x2*)(cb + 2 * cp);
#pragma unroll 1
    for (;;) {
        const int p0 = unit * 32;
#pragma unroll
        for (int i = 0; i < 8; ++i) { const int c = tid + 512 * i; const int row = c >> 6, ch = c & 63; if (c < 62 * 64) *(LAS u32x4*)(ut + row * 1024 + ch * 16) = tmp[i]; }
        __syncthreads();
        const int nu = unit + G; const bool has = nu < N_CONV_UNITS;
        if (has) conv_issue(UC, nu, tmp, tid);
#pragma unroll 1
        for (int grp = 0; grp < 2; ++grp) {
            const int base = half * 16 + grp * 8;
            f32x2 acc[8];
#pragma unroll
            for (int o = 0; o < 8; ++o) acc[o] = bias;
#pragma unroll
            for (int i = 0; i < 38; ++i) {
                const unsigned xw = *(const LAS unsigned*)(ut + (base + i) * 1024 + cp * 4);
                const f32x2 x = {bflo(xw), bfhi(xw)};
#pragma unroll
                for (int o = 0; o < 8; ++o) { const int k = i - o; if (k >= 0 && k <= 30) acc[o] += wk[k < 0 ? 0 : (k > 30 ? 30 : k)] * x; }
            }
#pragma unroll
            for (int o = 0; o < 8; ++o) *(LAS f32x2*)(ot + (base + o) * 512 + 2 * cp) = acc[o];
        }
        __syncthreads();
        const f32x4 g0 = *(const f32x4*)(lg + 8 * lane), g1 = *(const f32x4*)(lg + 8 * lane + 4), b0 = *(const f32x4*)(lb + 8 * lane), b1 = *(const f32x4*)(lb + 8 * lane + 4);
        float sa[4], sb[4]; f32x4 xa[4], xb[4];
#pragma unroll
        for (int pp = 0; pp < 4; ++pp) {
            const int pos = 4 * w + pp;
            xa[pp] = *(const LAS f32x4*)(ot + pos * 512 + 8 * lane); xb[pp] = *(const LAS f32x4*)(ot + pos * 512 + 8 * lane + 4);
            const f32x4 x0 = xa[pp], x1 = xb[pp];
            sa[pp] = (x0[0] + x0[1]) + (x0[2] + x0[3]) + (x1[0] + x1[1]) + (x1[2] + x1[3]);
            sb[pp] = (x0[0] * x0[0] + x0[1] * x0[1]) + (x0[2] * x0[2] + x0[3] * x0[3]) + (x1[0] * x1[0] + x1[1] * x1[1]) + (x1[2] * x1[2] + x1[3] * x1[3]);
        }
#pragma unroll
        for (int o = 1; o < 64; o <<= 1) {
#pragma unroll
            for (int pp = 0; pp < 4; ++pp) { sa[pp] += __shfl_xor(sa[pp], o); sb[pp] += __shfl_xor(sb[pp], o); }
        }
#pragma unroll
        for (int pp = 0; pp < 4; ++pp) {
            const int pos = 4 * w + pp;
            const float mean = sa[pp] * (1.f / 512.f), var = fmaxf(sb[pp] * (1.f / 512.f) - mean * mean, 0.f), rstd = rsqrtf(var + EPS);
            float y[8];
#pragma unroll
            for (int j = 0; j < 4; ++j) { y[j] = (xa[pp][j] - mean) * rstd * g0[j] + b0[j]; y[4 + j] = (xb[pp][j] - mean) * rstd * g1[j] + b1[j]; }
#pragma unroll
            for (int j = 0; j < 8; ++j) y[j] = y[j] * __builtin_amdgcn_rcpf(1.f + __expf(-y[j]));
            u32x4 wv; wv.x = pk2(y[0], y[1]); wv.y = pk2(y[2], y[3]); wv.z = pk2(y[4], y[5]); wv.w = pk2(y[6], y[7]);
            *(u32x4*)(MIX + (size_t)(p0 + pos) * 1024 + 512 + 8 * lane) = wv;
        }
        if (!has) break;
        unit = nu;
    }
    __syncthreads();
}

__device__ __forceinline__ void merge_phase(const bf16_t* __restrict__ OP, const float* __restrict__ LSE, bf16_t* MIX, int tid) {
    for (int idx = blockIdx.x * 512 + tid; idx < M * 64; idx += gridDim.x * 512) {
        const int row = idx >> 6, hc = idx & 63, h = hc >> 3;
        const float l0 = LSE[(size_t)row * 8 + h], l1 = LSE[(size_t)M * 8 + (size_t)row * 8 + h], l2 = LSE[(size_t)2 * M * 8 + (size_t)row * 8 + h];
        const float mx = fmaxf(l0, fmaxf(l1, l2));
        float w0 = exp2f(l0 - mx), w1 = exp2f(l1 - mx), w2 = exp2f(l2 - mx);
        const float inv = 1.f / (w0 + w1 + w2); w0 *= inv; w1 *= inv; w2 *= inv;
        const u32x4 a0 = *(const u32x4*)(OP + (size_t)row * 512 + hc * 8), a1 = *(const u32x4*)(OP + (size_t)M * 512 + (size_t)row * 512 + hc * 8), a2 = *(const u32x4*)(OP + (size_t)2 * M * 512 + (size_t)row * 512 + hc * 8);
        u32x4 wv;
#pragma unroll
        for (int q = 0; q < 4; ++q) {
            const float lo = w0 * bflo(a0[q]) + w1 * bflo(a1[q]) + w2 * bflo(a2[q]);
            const float hi = w0 * bfhi(a0[q]) + w1 * bfhi(a1[q]) + w2 * bfhi(a2[q]);
            wv[q] = pk2(lo, hi);
        }
        *(u32x4*)(MIX + (size_t)row * 1024 + hc * 8) = wv;
    }
}

constexpr int XP = 528, XPV = 544;
constexpr int N_XATTN_UNITS = BATCH * 4 * (SEQ / 256);
__device__ __forceinline__ void xattn_unit(LAS unsigned char* lds, const bf16_t* __restrict__ XQ, const bf16_t* __restrict__ XK, const bf16_t* __restrict__ XV, bf16_t* XO, int unit, int tid) {
    const int lane = tid & 63, w = __builtin_amdgcn_readfirstlane(tid >> 6), ql = lane & 15, g = lane >> 4;
    const int b = unit >> 7, xh = (unit >> 5) & 3, qb = unit & 31;
#pragma unroll 1
    for (int hb = 0; hb < 2; ++hb) {
        u32x4 tmp[8];
#pragma unroll
        for (int i = 0; i < 8; ++i) { const int c = tid + 512 * (8 * hb + i); const int row = c >> 5, ch = c & 31; tmp[i] = *(const u32x4*)(XK + (size_t)(b * NMEM + row) * 1024 + xh * 256 + ch * 8); }
#pragma unroll
        for (int i = 0; i < 8; ++i) { const int c = tid + 512 * (8 * hb + i); const int row = c >> 5, ch = c & 31; *(LAS u32x4*)(lds + row * XP + ch * 16) = tmp[i]; }
    }
    const size_t qrow0 = (size_t)b * SEQ + qb * 256 + 32 * w + ql;
    bf16x8 qf[2][8];
#pragma unroll
    for (int qt = 0; qt < 2; ++qt)
#pragma unroll
        for (int ks = 0; ks < 8; ++ks) qf[qt][ks] = *(const bf16x8*)(XQ + (qrow0 + 16 * qt) * 1024 + xh * 256 + 32 * ks + 8 * g);
    __syncthreads();
    f32x4 st[16][2];
    const LAS unsigned char* kp = lds + ql * XP + g * 16;
#pragma unroll
    for (int t = 0; t < 16; ++t) {
        f32x4 z0 = {0.f, 0.f, 0.f, 0.f}, z1 = {0.f, 0.f, 0.f, 0.f};
#pragma unroll
        for (int ks = 0; ks < 8; ++ks) { const bf16x8 kf = *(const LAS bf16x8*)(kp + t * 16 * XP + ks * 64); z0 = MFMA16(kf, qf[0][ks], z0); z1 = MFMA16(kf, qf[1][ks], z1); }
        st[t][0] = z0; st[t][1] = z1;
    }
    float inv[2];
    bf16x8 pf[2][8];
#pragma unroll
    for (int qt = 0; qt < 2; ++qt) {
        float mx = -1e30f;
#pragma unroll
        for (int t = 0; t < 16; ++t)
#pragma unroll
            for (int i = 0; i < 4; ++i) mx = fmaxf(mx, st[t][qt][i]);
        mx = fmaxf(mx, __shfl_xor(mx, 16)); mx = fmaxf(mx, __shfl_xor(mx, 32));
        float lsum = 0.f;
#pragma unroll
        for (int t = 0; t < 16; ++t)
#pragma unroll
            for (int i = 0; i < 4; ++i) { const float p = __builtin_amdgcn_exp2f(st[t][qt][i] - mx); st[t][qt][i] = p; lsum += p; }
        lsum += __shfl_xor(lsum, 16); lsum += __shfl_xor(lsum, 32);
        inv[qt] = __builtin_amdgcn_rcpf(lsum);
#pragma unroll
        for (int s = 0; s < 8; ++s) {
            u32x4 wv; wv.x = pk2(st[2 * s][qt][0], st[2 * s][qt][1]); wv.y = pk2(st[2 * s][qt][2], st[2 * s][qt][3]);
            wv.z = pk2(st[2 * s + 1][qt][0], st[2 * s + 1][qt][1]); wv.w = pk2(st[2 * s + 1][qt][2], st[2 * s + 1][qt][3]);
            pf[qt][s] = __builtin_bit_cast(bf16x8, wv);
        }
    }
    __syncthreads();
#pragma unroll 1
    for (int hb = 0; hb < 2; ++hb) {
        u32x4 tmp[8];
#pragma unroll
        for (int i = 0; i < 8; ++i) { const int c = tid + 512 * (8 * hb + i); const int row = c >> 5, ch = c & 31; tmp[i] = *(const u32x4*)(XV + (size_t)(b * NMEM + row) * 1024 + xh * 256 + ch * 8); }
#pragma unroll
        for (int i = 0; i < 8; ++i) { const int c = tid + 512 * (8 * hb + i); const int row = c >> 5, ch = c & 31; *(LAS u32x4*)(lds + row * XPV + ch * 16) = tmp[i]; }
    }
    __syncthreads();
    const LAS unsigned char* vp = lds + (4 * g + (ql >> 2)) * XPV + (ql & 3) * 8;
#pragma unroll
    for (int hf = 0; hf < 2; ++hf) {
        f32x4 o[8][2];
#pragma unroll
        for (int dd = 0; dd < 8; ++dd) { o[dd][0] = (f32x4){0.f, 0.f, 0.f, 0.f}; o[dd][1] = (f32x4){0.f, 0.f, 0.f, 0.f}; }
#pragma unroll
        for (int s = 0; s < 8; ++s)
#pragma unroll
            for (int dd = 0; dd < 8; ++dd) {
                const int dt = hf * 8 + dd;
                const s16x4 lo = vtr(vp + (32 * s) * XPV + dt * 32), hi = vtr(vp + (32 * s + 16) * XPV + dt * 32);
                const bf16x8 vf = {lo[0], lo[1], lo[2], lo[3], hi[0], hi[1], hi[2], hi[3]};
                o[dd][0] = MFMA16(vf, pf[0][s], o[dd][0]); o[dd][1] = MFMA16(vf, pf[1][s], o[dd][1]);
            }
#pragma unroll
        for (int qt = 0; qt < 2; ++qt)
#pragma unroll
            for (int dd = 0; dd < 8; ++dd) {
                u32x2 wv; wv.x = pk2(o[dd][qt][0] * inv[qt], o[dd][qt][1] * inv[qt]); wv.y = pk2(o[dd][qt][2] * inv[qt], o[dd][qt][3] * inv[qt]);
                *(u32x2*)(XO + (qrow0 + 16 * qt) * 1024 + xh * 256 + 16 * (hf * 8 + dd) + 4 * g) = wv;
            }
    }
    __syncthreads();
}

__device__ __forceinline__ void final_phase(float* out, const bf16_t* __restrict__ hb, const float* __restrict__ ss, const float* __restrict__ gfin, int tid) {
    const int lane = tid & 63, wave = tid >> 6;
    for (int row = blockIdx.x * 8 + wave; row < M; row += gridDim.x * 8) {
        float s = ss[(size_t)row * 16 + (lane & 15)];
        s += __shfl_xor(s, 1); s += __shfl_xor(s, 2); s += __shfl_xor(s, 4); s += __shfl_xor(s, 8);
        const float rstd = rsqrtf(s * (1.f / D) + EPS);
#pragma unroll
        for (int j = 0; j < 2; ++j) {
            const int col = 8 * lane + 512 * j;
            const u32x4 w = *(const u32x4*)(hb + (size_t)row * D + col);
            const f32x4 g0 = *(const f32x4*)(gfin + col), g1 = *(const f32x4*)(gfin + col + 4);
            const f32x4 v0 = {bflo(w.x), bfhi(w.x), bflo(w.y), bfhi(w.y)}, v1 = {bflo(w.z), bfhi(w.z), bflo(w.w), bfhi(w.w)};
            *(f32x4*)(out + (size_t)row * D + col) = v0 * rstd * g0; *(f32x4*)(out + (size_t)row * D + col + 4) = v1 * rstd * g1;
        }
    }
}

#define XB_TMO      128
#define XB_XCNT(j)  (256  + 64 * (j))
#define XB_XSUB(j)  (1280 + 64 * (j))
#define XB_XGEN(j)  (2304 + 64 * (j))
#define XB_TOP      3328
#define XB_TOPGEN   3392
#define XCD_BAR_WORDS 3456
#define XB_SPIN_CAP (1u << 18)

__device__ __forceinline__ unsigned xb_ld(unsigned* p)              { return __hip_atomic_load(p, __ATOMIC_RELAXED, __HIP_MEMORY_SCOPE_AGENT); }
__device__ __forceinline__ unsigned xb_add(unsigned* p, unsigned v) { return __hip_atomic_fetch_add(p, v, __ATOMIC_RELAXED, __HIP_MEMORY_SCOPE_AGENT); }
__device__ __forceinline__ unsigned xb_xcc_id() { return (unsigned)__builtin_amdgcn_s_getreg((3 << 11) | 20) & 0xFu; }
#define XB_SPIN(cond, bar) do { unsigned _sp = 0; while (cond) { __builtin_amdgcn_s_sleep(1); \
    if ((++_sp & 255u) == 0u) { if (xb_ld(&(bar)[XB_TMO])) break; if (_sp > XB_SPIN_CAP) { atomicAdd(&(bar)[XB_TMO], 1u); break; } } } } while (0)

struct XcdBarrier {
    unsigned* bar; unsigned x;
    volatile LAS unsigned* st;
};

__device__ __forceinline__ XcdBarrier xcd_barrier_post(unsigned* bar, volatile LAS unsigned* st) {
    XcdBarrier b; b.bar = bar; b.x = xb_xcc_id(); b.st = st;
    if (threadIdx.x == 0) (void)xb_add(&bar[XB_XCNT(b.x)], 1u);
    return b;
}
__device__ __forceinline__ void xcd_barrier_complete(unsigned* bar, unsigned x, unsigned& nloc, unsigned& nx) {
    const unsigned G = gridDim.x * gridDim.y * gridDim.z;
    unsigned sum, cnt, mine, sp = 0u;
    for (;;) {
        sum = 0u; cnt = 0u; mine = 0u;
#pragma unroll
        for (unsigned j = 0; j < 16; ++j) { const unsigned c = xb_ld(&bar[XB_XCNT(j)]); sum += c; cnt += (c > 0u) ? 1u : 0u; mine = (j == x) ? c : mine; }
        if (sum == G) break;
        __builtin_amdgcn_s_sleep(1);
        if ((++sp & 255u) == 0u) { if (xb_ld(&bar[XB_TMO])) break; if (sp > XB_SPIN_CAP) { atomicAdd(&bar[XB_TMO], 1u); break; } }
    }
    nloc = mine > 0u ? mine : 1u; nx = cnt > 0u ? cnt : 1u;
}

__device__ __forceinline__ void xcd_barrier(const XcdBarrier& b) {
    asm volatile("s_waitcnt vmcnt(0)" ::: "memory");
    __syncthreads();
    if (threadIdx.x == 0) {
        unsigned* bar = b.bar;
        __builtin_amdgcn_s_waitcnt(0);
        unsigned nloc = b.st[0], nx = b.st[1];
        if (nloc == 0u) { xcd_barrier_complete(bar, b.x, nloc, nx); b.st[0] = nloc; b.st[1] = nx; }
        const unsigned old = xb_add(&bar[XB_XSUB(b.x)], 1u);
        const unsigned gen = old / nloc;
        if (old + 1u == (gen + 1u) * nloc) {
            __builtin_amdgcn_fence(__ATOMIC_RELEASE, "agent");
            asm volatile("s_waitcnt vmcnt(0)" ::: "memory");
            const unsigned og = xb_add(&bar[XB_TOP], 1u);
            const unsigned tg = og / nx;
            if (og + 1u == (tg + 1u) * nx) xb_add(&bar[XB_TOPGEN], 1u);
            else XB_SPIN(xb_ld(&bar[XB_TOPGEN]) == tg, bar);
            __builtin_amdgcn_fence(__ATOMIC_ACQUIRE, "agent");
            xb_add(&bar[XB_XGEN(b.x)], 1u);
            asm volatile("s_waitcnt vmcnt(0)" ::: "memory");
        } else {
            XB_SPIN(xb_ld(&bar[XB_XGEN(b.x)]) == gen, bar);
            __builtin_amdgcn_fence(__ATOMIC_ACQUIRE, "agent");
            asm volatile("s_waitcnt vmcnt(0)" ::: "memory");
        }
    }
    __syncthreads();
}


__global__ void __launch_bounds__(512, 2) fwd_megakernel(Args a) {
    extern __shared__ __attribute__((aligned(16))) unsigned char lds_raw[];
    LAS unsigned char* lds = (LAS unsigned char*)lds_raw;
    const int tid = threadIdx.x;
    unsigned char* ws = a.ws;
    const int lo = a.ph_lo, hi = a.ph_hi;
    const int G = gridDim.x, c = blockIdx.x;
    const int vc = (G % 8 == 0) ? (c % 8) * (G / 8) + c / 8 : c;
    bf16_t* XN = (bf16_t*)(ws + WS_XN);
    volatile LAS unsigned* bst = (volatile LAS unsigned*)(lds + LDS_BYTES - 64);
    if (tid == 0) { bst[0] = 0u; bst[1] = 0u; }
    __syncthreads();
    XcdBarrier bar = xcd_barrier_post((unsigned*)ws, bst);
    if (a.ph_hi < 0) cg::this_grid().sync();
#define IN(k) (lo <= (k) && (k) < hi)
#ifndef PROBE_PH
#define PROBE_PH (-1)
#endif
#if PROBE_PH >= 0
    unsigned long long tA = 0, tB = 0;
#define STAMP(k) do { if ((k) == PROBE_PH - 1) tA = __builtin_amdgcn_s_memrealtime(); if ((k) == PROBE_PH) tB = __builtin_amdgcn_s_memrealtime(); } while (0)
#else
#define STAMP(k) do { } while (0)
#endif
#define SEAM(k) do { if (IN(k) && IN((k) + 1)) xcd_barrier(bar); STAMP(k); } while (0)
    STAMP(-1);

#ifndef PROBE_P0
#define PROBE_P0 0
#define PROBE_P2 0
#define PROBE_P6 0
#define PROBE_SYNC 0
#define PROBE_P3 0
#endif
    if (IN(0)) p0_prologue(lds, a, tid);
#if PROBE_P0
    if (IN(0)) p0_prologue(lds, a, tid);
#endif
    #if PROBE_SYNC
    _Pragma("unroll 1") for (int rep = 0; rep < PROBE_SYNC; ++rep) xcd_barrier(bar);
#endif
    SEAM(0);
    if (IN(1)) {
        { pg8::Gemm g{XN, (const bf16_t*)(ws + WS_WIN), M, DIN, D}; pg8::StaticOrder S; S.init(M, DIN, G, c);
          EpiIn E{(bf16_t*)(ws + WS_QB), (bf16_t*)(ws + WS_KB), (bf16_t*)(ws + WS_VB), (bf16_t*)(ws + WS_UC), (const float*)(ws + WS_CS)};
          pg8::gemm_phase<EpiIn, pg8::StaticOrder, true, true>(lds, g, S, E); }
        { const int c2 = (c + G - (640 % G)) % G;
          pg8::Gemm g{(const bf16_t*)(ws + WS_MN), (const bf16_t*)(ws + WS_WXKV), MM, 2048, D}; pg8::StaticOrder S; S.init(MM, 2048, G, c2);
          EpiKV E{(bf16_t*)(ws + WS_XK), (bf16_t*)(ws + WS_XV)};
          pg8::gemm_phase<EpiKV, pg8::StaticOrder, true, true>(lds, g, S, E);
          const int nidle = (G == 256) ? 112 : G; const int hw = (G == 256) ? c2 - 16 : c;
          if (hw >= 0 && hw < nidle) { __syncthreads(); late_weights(lds, a, tid, hw, nidle); } }
    }
    SEAM(1);
    if (IN(2)) {
        dattn_phase(lds, (const bf16_t*)(ws + WS_QB), (const bf16_t*)(ws + WS_KB), (const bf16_t*)(ws + WS_VB), (bf16_t*)(ws + WS_OP), (float*)(ws + WS_LSE), vc, G, tid);
#ifdef PROBE_DUP_DATTN
        dattn_phase(lds, (const bf16_t*)(ws + WS_QB), (const bf16_t*)(ws + WS_KB), (const bf16_t*)(ws + WS_VB), (bf16_t*)(ws + WS_OP), (float*)(ws + WS_LSE), vc, G, tid);
#endif
        conv_phase(lds, (const bf16_t*)(ws + WS_UC), a.in[4], a.in[5], a.in[6], a.in[7], (bf16_t*)(ws + WS_MIX), vc, G, tid);
    }
    #if PROBE_P2
    __syncthreads();
if (IN(2)) {
        dattn_phase(lds, (const bf16_t*)(ws + WS_QB), (const bf16_t*)(ws + WS_KB), (const bf16_t*)(ws + WS_VB), (bf16_t*)(ws + WS_OP), (float*)(ws + WS_LSE), vc, G, tid);
        conv_phase(lds, (const bf16_t*)(ws + WS_UC), a.in[4], a.in[5], a.in[6], a.in[7], (bf16_t*)(ws + WS_MIX), vc, G, tid);
    }
    #endif
    SEAM(2);
    if (IN(3)) merge_phase((const bf16_t*)(ws + WS_OP), (const float*)(ws + WS_LSE), (bf16_t*)(ws + WS_MIX), tid);
    #if PROBE_P3
if (IN(3)) merge_phase((const bf16_t*)(ws + WS_OP), (const float*)(ws + WS_LSE), (bf16_t*)(ws + WS_MIX), tid);
    #endif
    SEAM(3);
    if (IN(4)) { pg8::Gemm g{(const bf16_t*)(ws + WS_MIX), (const bf16_t*)(ws + WS_WOUT), M, D, D}; pg8::StaticOrder S; S.init(M, D, G, c);
        EpiRes<false, false, true> E{a.in[0], nullptr, nullptr, XN, (float*)(ws + WS_SS1)};
        pg8::gemm_phase<EpiRes<false, false, true>, pg8::StaticOrder, true, true>(lds, g, S, E); }
    SEAM(4);
    if (IN(5)) { pg8::Gemm g{XN, (const bf16_t*)(ws + WS_WXQ), M, D, D}; pg8::StaticOrder S; S.init(M, D, G, c);
        EpiScale<0> E{(bf16_t*)(ws + WS_XQ), D, (const float*)(ws + WS_SS1), XQSCALE};
        pg8::gemm_phase<EpiScale<0>, pg8::StaticOrder, true, true>(lds, g, S, E); }
    SEAM(5);
    if (IN(6)) { for (int u = vc; u < N_XATTN_UNITS; u += G) xattn_unit(lds, (const bf16_t*)(ws + WS_XQ), (const bf16_t*)(ws + WS_XK), (const bf16_t*)(ws + WS_XV), (bf16_t*)(ws + WS_XO), u, tid); }
    #if PROBE_P6
if (IN(6)) { for (int u = vc; u < N_XATTN_UNITS; u += G) xattn_unit(lds, (const bf16_t*)(ws + WS_XQ), (const bf16_t*)(ws + WS_XK), (const bf16_t*)(ws + WS_XV), (bf16_t*)(ws + WS_XO), u, tid); }
    #endif
    SEAM(6);
    if (IN(7)) { pg8::Gemm g{(const bf16_t*)(ws + WS_XO), (const bf16_t*)(ws + WS_WXO), M, D, D}; pg8::StaticOrder S; S.init(M, D, G, c);
        EpiRes<true, false, true> E{nullptr, XN, nullptr, XN, (float*)(ws + WS_SS2)};
        pg8::gemm_phase<EpiRes<true, false, true>, pg8::StaticOrder, true, true>(lds, g, S, E); }
    SEAM(7);
    if (IN(8)) { pg8::Gemm g{XN, (const bf16_t*)(ws + WS_WUP), M, FF, D}; pg8::StaticOrder S; S.init(M, FF, G, c);
        EpiScale<1> E{(bf16_t*)(ws + WS_U), FF, (const float*)(ws + WS_SS2), 1.f};
        pg8::gemm_phase<EpiScale<1>, pg8::StaticOrder, true, true>(lds, g, S, E); }
    SEAM(8);
    if (IN(9)) { pg8::Gemm g{(const bf16_t*)(ws + WS_U), (const bf16_t*)(ws + WS_WDN), M, D, FF}; pg8::StaticOrder S; S.init(M, D, G, c);
        EpiRes<true, false, true> E{nullptr, XN, nullptr, XN, (float*)(ws + WS_SS3)};
        pg8::gemm_phase<EpiRes<true, false, true>, pg8::StaticOrder, true, true>(lds, g, S, E); }
    SEAM(9);
    if (IN(10)) final_phase(a.out, XN, (const float*)(ws + WS_SS3), a.in[18], tid);
    STAMP(10);
#if PROBE_PH >= 0
    if (c == 0 && tid == 0) { const unsigned long long dly = (tB - tA) * 4ull, t0 = __builtin_amdgcn_s_memrealtime(); while (__builtin_amdgcn_s_memrealtime() - t0 < dly) __builtin_amdgcn_s_sleep(20); }
#endif
#undef IN
#undef SEAM
}

#ifndef MK_SPLIT
#define MK_SPLIT 0
#endif
extern "C" void kernel_launch(void* const* d_in, const int* in_sizes, int n_in, void* d_out, int out_size, void* d_ws, size_t ws_size, hipStream_t stream) {
    static int grid = 0;
    if (grid == 0) {
        int dev = 0, cus = 0, per_cu = 0;
        hipGetDevice(&dev);
        hipDeviceGetAttribute(&cus, hipDeviceAttributeMultiprocessorCount, dev);
        if (hipFuncSetAttribute((const void*)fwd_megakernel, hipFuncAttributeMaxDynamicSharedMemorySize, LDS_BYTES) != hipSuccess) fprintf(stderr, "kernel_launch: hipFuncSetAttribute failed\n");
        if (hipOccupancyMaxActiveBlocksPerMultiprocessor(&per_cu, (const void*)fwd_megakernel, 512, LDS_BYTES) != hipSuccess || per_cu < 1) { fprintf(stderr, "kernel_launch: occupancy query says %d\n", per_cu); per_cu = 1; }
        (void)hipGetLastError();
        grid = cus > 0 ? cus : 256;
        if (n_in != 19 || ws_size < WS_END) fprintf(stderr, "kernel_launch: unexpected n_in %d / ws_size %zu\n", n_in, ws_size);
    }
    Args a{};
    for (int i = 0; i < 19; ++i) a.in[i] = (const float*)d_in[i];
    a.out = (float*)d_out; a.ws = (unsigned char*)d_ws;
#if MK_SPLIT
    for (int p = 0; p < NPH; ++p) { a.ph_lo = p; a.ph_hi = p + 1; hipLaunchKernelGGL(fwd_megakernel, dim3(grid), dim3(512), LDS_BYTES, stream, a); }
#else
    a.ph_lo = 0; a.ph_hi = NPH;
    if (hipMemsetAsync(d_ws, 0, 16384, stream) != hipSuccess) fprintf(stderr, "kernel_launch: memset of the barrier words failed\n");
    void* args[] = {&a};
    hipError_t e = hipLaunchCooperativeKernel((const void*)fwd_megakernel, dim3(grid), dim3(512), args, LDS_BYTES, stream);
    if (e != hipSuccess) fprintf(stderr, "kernel_launch: cooperative launch failed: %s (grid %d)\n", hipGetErrorString(e), grid);
#endif
}
```
